# Optimizing an MI355X kernel written in HIP

```python
import math
import jax, jax.numpy as jnp
from jax import lax
import numpy as np

D_MODEL = 1024
BATCH = 4
SEQ = 4096
DEPTH = 2

GRID_W = 64
CTX_LEN = 256
EPS = 1e-6
N_BRANCH = 4
BRANCH_W = D_MODEL // 2

SSD_HEADS = 8
SSD_HEAD_DIM = BRANCH_W // SSD_HEADS
SSD_INNER = SSD_HEADS * SSD_HEAD_DIM
SSD_GROUPS = 2
SSD_STATE = 128
SSD_CHUNK = 128
SSD_XBC = SSD_INNER + 2 * SSD_GROUPS * SSD_STATE
CONV_W = 4

GLA_HEADS = 4
GLA_DK = BRANCH_W // GLA_HEADS
GLA_DV = GLA_DK
GLA_RANK = 16
GLA_GATE_NORM = 16.0
GLA_CHUNK = 64

LRU_W = BRANCH_W
LRU_BLOCKS = 8
LRU_BLOCK = LRU_W // LRU_BLOCKS
LRU_C = 8.0

ATT_HEADS = 4
ATT_KV_HEADS = 2
ATT_HEAD_DIM = BRANCH_W // ATT_HEADS
ATT_BLOCK = 128
ROPE_THETA = 10000.0

MOE_GROUPS = 4
MOE_PER_GROUP = 4
MOE_EXPERTS = MOE_GROUPS * MOE_PER_GROUP
MOE_TOPK = 2
MOE_FF = D_MODEL // 2

IN_SIZES = (
    SSD_INNER,
    SSD_XBC,
    2 * SSD_HEADS,
    GLA_HEADS * GLA_DK,
    GLA_HEADS * GLA_DK,
    GLA_HEADS * GLA_DV,
    2 * GLA_RANK,
    GLA_HEADS * GLA_DV,
    LRU_W,
    LRU_W,
    ATT_HEADS * ATT_HEAD_DIM,
    ATT_KV_HEADS * ATT_HEAD_DIM,
    ATT_KV_HEADS * ATT_HEAD_DIM,
    N_BRANCH * D_MODEL,
)
IN_WIDTH = sum(IN_SIZES)

kernel_name = 'hybrid_ssd_gla_rglru_gqa_hmoe_diffusion_block'

F32 = jnp.float32


def rms_norm(x, g):
    xf = x.astype(F32)
    y = xf * lax.rsqrt(jnp.mean(xf * xf, axis=-1, keepdims=True) + EPS)
    return (y * g.astype(F32)).astype(x.dtype)


def split_in(p):
    out, o = [], 0
    for s in IN_SIZES:
        out.append(p[..., o:o + s])
        o += s
    return out


def dw_conv(x, w, b):
    k = w.shape[0]
    y = lax.conv_general_dilated(x, w[:, None, :].astype(x.dtype), window_strides=(1,),
                                 padding=[(k // 2, k - 1 - k // 2)],
                                 dimension_numbers=('NWC', 'WIO', 'NWC'),
                                 feature_group_count=x.shape[-1])
    return y + b.astype(x.dtype)


def ssd_scan(xh, dt, a, bm, cm, h0, with_y):
    bsz, L, H, P = xh.shape
    G, N = bm.shape[2], bm.shape[3]
    E = H // G
    Q = min(SSD_CHUNK, L)
    nc = L // Q
    dtc = dt.astype(F32).reshape(bsz, nc, Q, G, E)
    dtx = xh.astype(F32).reshape(bsz, nc, Q, G, E, P) * dtc[..., None]
    b = bm.astype(F32).reshape(bsz, nc, Q, G, N)
    acum = jnp.cumsum(dtc * a.astype(F32).reshape(G, E), axis=2)
    a_last = acum[:, :, -1]
    states = jnp.einsum('bclgn,bclge,bclgep->bcgepn', b, jnp.exp(a_last[:, :, None] - acum), dtx)

    def step(h, inp):
        s, al = inp
        return jnp.exp(al)[..., None, None] * h + s, h

    h_fin, h_starts = lax.scan(step, h0.astype(F32).reshape(bsz, G, E, P, N),
                               (jnp.moveaxis(states, 1, 0), jnp.moveaxis(a_last, 1, 0)))
    h_fin = h_fin.reshape(bsz, H, P, N)
    if not with_y:
        return None, h_fin
    h_starts = jnp.moveaxis(h_starts, 0, 1)
    c = cm.astype(F32).reshape(bsz, nc, Q, G, N)
    seg = acum[:, :, :, None] - acum[:, :, None]
    causal = jnp.tril(jnp.ones((Q, Q), bool))[:, :, None, None]
    lmat = jnp.exp(jnp.where(causal, seg, -jnp.inf))
    cb = jnp.einsum('bcign,bcjgn->bcijg', c, b)
    y_diag = jnp.einsum('bcijge,bcjgep->bcigep', cb[..., None] * lmat, dtx)
    y_off = jnp.einsum('bcign,bcige,bcgepn->bcigep', c, jnp.exp(acum), h_starts)
    return (y_diag + y_off).reshape(bsz, L, H, P), h_fin


def ssd_seq(z, xbc, dt_raw, lp, h0_f, h0_b, with_y):
    bsz, L, _ = xbc.shape
    xbc = jax.nn.silu(dw_conv(xbc, lp['ssd_conv_w'], lp['ssd_conv_b']))
    xs = xbc[..., :SSD_INNER]
    bm = xbc[..., SSD_INNER:SSD_INNER + SSD_GROUPS * SSD_STATE].reshape(bsz, L, SSD_GROUPS, SSD_STATE)
    cm = xbc[..., SSD_INNER + SSD_GROUPS * SSD_STATE:].reshape(bsz, L, SSD_GROUPS, SSD_STATE)
    xh = xs.reshape(bsz, L, SSD_HEADS, SSD_HEAD_DIM)
    dt = jax.nn.softplus(dt_raw.astype(F32).reshape(bsz, L, 2, SSD_HEADS) + lp['ssd_dt_bias'].astype(F32))
    a = -jnp.exp(lp['ssd_a_log'].astype(F32))
    yf, hf = ssd_scan(xh, dt[:, :, 0], a[0], bm, cm, h0_f, with_y)
    yb, hb = ssd_scan(xh[:, ::-1], dt[:, ::-1, 1], a[1], bm[:, ::-1], cm[:, ::-1], h0_b, with_y)
    if not with_y:
        return None, hf, hb
    y = yf + yb[:, ::-1] + lp['ssd_d'].astype(F32)[:, None] * xh.astype(F32)
    y = y.reshape(bsz, L, SSD_INNER) * jax.nn.silu(z.astype(F32))
    return rms_norm(y, lp['ssd_norm']).astype(z.dtype), hf, hb


def gla_scan(q, k, v, g, s0, with_y):
    bsz, L, H, K = k.shape
    V = v.shape[-1]
    Q = min(GLA_CHUNK, L)
    nc = L // Q
    k = k.reshape(bsz, nc, Q, H, K)
    v = v.reshape(bsz, nc, Q, H, V)
    gc = jnp.cumsum(g.reshape(bsz, nc, Q, H, K), axis=2)
    g_last = gc[:, :, -1]
    chunk_kv = jnp.einsum('bclhk,bclhv->bchkv', k * jnp.exp(g_last[:, :, None] - gc), v)

    def step(s, inp):
        kv, gl = inp
        return jnp.exp(gl)[..., None] * s + kv, s

    s_fin, s_starts = lax.scan(step, s0.astype(F32),
                               (jnp.moveaxis(chunk_kv, 1, 0), jnp.moveaxis(g_last, 1, 0)))
    if not with_y:
        return None, s_fin
    q = q.reshape(bsz, nc, Q, H, K)
    s_starts = jnp.moveaxis(s_starts, 0, 1)
    o_inter = jnp.einsum('bclhk,bchkv->bclhv', q * jnp.exp(gc), s_starts)
    g_ref = gc[:, :, Q // 2:Q // 2 + 1]
    att = jnp.einsum('bcihk,bcjhk->bchij', q * jnp.exp(gc - g_ref), k * jnp.exp(g_ref - gc))
    att = jnp.where(jnp.tril(jnp.ones((Q, Q), bool)), att, 0.0)
    o_intra = jnp.einsum('bchij,bcjhv->bcihv', att, v)
    return (o_inter + o_intra).reshape(bsz, L, H, V), s_fin


def gla_seq(q, k, v, g1, r, lp, s0_f, s0_b, with_y):
    bsz, L, _ = k.shape
    q = q.astype(F32).reshape(bsz, L, GLA_HEADS, GLA_DK) * (GLA_DK ** -0.5)
    k = k.astype(F32).reshape(bsz, L, GLA_HEADS, GLA_DK)
    v = v.astype(F32).reshape(bsz, L, GLA_HEADS, GLA_DV)
    logit = jnp.einsum('bldr,drk->bldk', g1.astype(F32).reshape(bsz, L, 2, GLA_RANK),
                       lp['gla_g2'].astype(F32)) + lp['gla_gb'].astype(F32)
    g = (jax.nn.log_sigmoid(logit) / GLA_GATE_NORM).reshape(bsz, L, 2, GLA_HEADS, GLA_DK)
    of, sf = gla_scan(q, k, v, g[:, :, 0], s0_f, with_y)
    ob, sb = gla_scan(q[:, ::-1], k[:, ::-1], v[:, ::-1], g[:, ::-1, 1], s0_b, with_y)
    if not with_y:
        return None, sf, sb
    o = rms_norm(of + ob[:, ::-1], lp['gla_norm'].reshape(GLA_HEADS, GLA_DV))
    y = o.reshape(bsz, L, GLA_HEADS * GLA_DV) * jax.nn.silu(r.astype(F32))
    return y.astype(r.dtype), sf, sb


def lru_gates(u, lp, d):
    bsz, L, W = u.shape
    ub = u.reshape(bsz, L, LRU_BLOCKS, LRU_BLOCK)
    r = jax.nn.sigmoid(jnp.einsum('blnc,ncd->blnd', ub, lp['lru_wa'][d].astype(F32)).reshape(bsz, L, W)
                       + lp['lru_ba'][d].astype(F32))
    i = jax.nn.sigmoid(jnp.einsum('blnc,ncd->blnd', ub, lp['lru_wx'][d].astype(F32)).reshape(bsz, L, W)
                       + lp['lru_bx'][d].astype(F32))
    log_a = -LRU_C * jax.nn.softplus(-lp['lru_lambda'][d].astype(F32)) * r
    return log_a, u * i * jnp.sqrt(-jnp.expm1(2.0 * log_a))


def lru_scan(v, log_a, h0):
    def comb(left, right):
        al, bl = left
        ar, br = right
        return al * ar, ar * bl + br
    a_cum, h = lax.associative_scan(comb, (jnp.exp(log_a), v), axis=1)
    return h + a_cum * h0[:, None]


def lru_seq(xb, gb, lp, h0_f, h0_b, with_y):
    u = dw_conv(xb, lp['lru_conv_w'], lp['lru_conv_b']).astype(F32)
    la_f, v_f = lru_gates(u, lp, 0)
    la_b, v_b = lru_gates(u[:, ::-1], lp, 1)
    hf = lru_scan(v_f, la_f, h0_f)
    hb = lru_scan(v_b, la_b, h0_b)
    if not with_y:
        return None, hf[:, -1], hb[:, -1]
    y = (hf + hb[:, ::-1]) * jax.nn.gelu(gb.astype(F32))
    return y.astype(xb.dtype), hf[:, -1], hb[:, -1]


def rope_1d(x, pos):
    f = x.shape[-1] // 2
    inv = ROPE_THETA ** (-jnp.arange(f, dtype=F32) / f)
    ang = pos.astype(F32)[:, None] * inv
    cos, sin = jnp.cos(ang)[None, :, None], jnp.sin(ang)[None, :, None]
    x1, x2 = x[..., :f].astype(F32), x[..., f:].astype(F32)
    return jnp.concatenate([x1 * cos - x2 * sin, x1 * sin + x2 * cos], axis=-1)


def rope_2d(x, row, col):
    h = x.shape[-1] // 2
    return jnp.concatenate([rope_1d(x[..., :h], row), rope_1d(x[..., h:], col)], axis=-1)


def attn_softmax(q, k, v):
    s = jnp.einsum('bqgrd,bkgd->bgrqk', q, k) * (ATT_HEAD_DIM ** -0.5)
    p = jax.nn.softmax(s, axis=-1)
    return jnp.einsum('bgrqk,bkgd->bqgrd', p, v)


def attn_mixer(qc, kc, vc, ql, kl, vl, lp, row, col, with_ctx):
    bsz, L, _ = ql.shape
    C = kc.shape[1]
    rep = ATT_HEADS // ATT_KV_HEADS
    heads = lambda t, n: t.reshape(t.shape[0], t.shape[1], n, ATT_HEAD_DIM)
    kc_h = rms_norm(heads(kc, ATT_KV_HEADS), lp['att_knorm']).astype(F32)
    vc_h = heads(vc, ATT_KV_HEADS).astype(F32)
    ql_h = rope_2d(rms_norm(heads(ql, ATT_HEADS), lp['att_qnorm']), row, col)
    kl_h = rope_2d(rms_norm(heads(kl, ATT_KV_HEADS), lp['att_knorm']), row, col)
    k_all = jnp.concatenate([kc_h, kl_h], axis=1)
    v_all = jnp.concatenate([vc_h, heads(vl, ATT_KV_HEADS).astype(F32)], axis=1)
    nb = L // ATT_BLOCK
    q_blocks = jnp.moveaxis(ql_h.reshape(bsz, nb, ATT_BLOCK, ATT_KV_HEADS, rep, ATT_HEAD_DIM), 1, 0)
    o = lax.map(lambda qb: attn_softmax(qb, k_all, v_all), q_blocks)
    y_lat = jnp.moveaxis(o, 0, 1).reshape(bsz, L, ATT_HEADS * ATT_HEAD_DIM).astype(ql.dtype)
    if not with_ctx:
        return None, y_lat
    qc_h = rms_norm(heads(qc, ATT_HEADS), lp['att_qnorm']).astype(F32)
    oc = attn_softmax(qc_h.reshape(bsz, C, ATT_KV_HEADS, rep, ATT_HEAD_DIM), kc_h, vc_h)
    return oc.reshape(bsz, C, ATT_HEADS * ATT_HEAD_DIM).astype(qc.dtype), y_lat


def merge_branches(ys, gate_raw, lp):
    gates = jax.nn.sigmoid(gate_raw)
    acc = sum(gates[..., n * D_MODEL:(n + 1) * D_MODEL] * (y @ lp['w_branch'][n]) for n, y in enumerate(ys))
    return acc @ lp['w_out']


def hier_moe(h, lp):
    T = h.shape[0]
    hf = h.astype(F32)
    lg = hf @ lp['router_wg'].astype(F32) + lp['router_bg'].astype(F32)
    pg = jax.nn.softmax(lg, axis=-1)
    _, gi = lax.top_k(lg, 1)
    gsel = jax.nn.one_hot(gi[:, 0], MOE_GROUPS, dtype=F32)
    le = (hf @ lp['router_we'].astype(F32) + lp['router_be'].astype(F32)).reshape(T, MOE_GROUPS, MOE_PER_GROUP)
    pe = jax.nn.softmax(jnp.einsum('tg,tge->te', gsel, le), axis=-1)
    tv, ti = lax.top_k(pe, MOE_TOPK)
    tv = tv / jnp.sum(tv, axis=-1, keepdims=True)
    w_in_grp = jnp.einsum('tk,tke->te', tv, jax.nn.one_hot(ti, MOE_PER_GROUP, dtype=F32))
    w = ((gsel * pg)[:, :, None] * w_in_grp[:, None, :]).reshape(T, MOE_EXPERTS).astype(h.dtype)
    out = jnp.zeros_like(h)
    for e in range(MOE_EXPERTS):
        a = jax.nn.silu(h @ lp['exp_w1'][e]) * (h @ lp['exp_w3'][e])
        out = out + w[:, e:e + 1] * (a @ lp['exp_w2'][e])
    return out


def hybrid_layer(xl, xc, mod_l, mod_c, lp, row, col, with_ctx):
    bsz, _, D = xl.shape
    C = xc.shape[1]
    sh1, sc1, g1, sh2, sc2, g2 = jnp.split(mod_l[:, None, :], 6, axis=-1)
    csh1, csc1, cg1, csh2, csc2, cg2 = jnp.split(mod_c, 6, axis=-1)
    hl = rms_norm(xl, lp['norm1']) * (1 + sc1) + sh1
    hc = rms_norm(xc, lp['norm1']) * (1 + csc1) + csh1
    pl = split_in(hl @ lp['w_in'])
    pc = split_in(hc @ lp['w_in'])
    z_ssd = jnp.zeros((bsz, SSD_HEADS, SSD_HEAD_DIM, SSD_STATE), F32)
    z_gla = jnp.zeros((bsz, GLA_HEADS, GLA_DK, GLA_DV), F32)
    z_lru = jnp.zeros((bsz, LRU_W), F32)
    yc_a, sf, sb = ssd_seq(pc[0], pc[1], pc[2], lp, z_ssd, z_ssd, with_ctx)
    yl_a, _, _ = ssd_seq(pl[0], pl[1], pl[2], lp, sf, sb, True)
    yc_b, sf, sb = gla_seq(pc[3], pc[4], pc[5], pc[6], pc[7], lp, z_gla, z_gla, with_ctx)
    yl_b, _, _ = gla_seq(pl[3], pl[4], pl[5], pl[6], pl[7], lp, sf, sb, True)
    yc_c, sf, sb = lru_seq(pc[8], pc[9], lp, z_lru, z_lru, with_ctx)
    yl_c, _, _ = lru_seq(pl[8], pl[9], lp, sf, sb, True)
    yc_d, yl_d = attn_mixer(pc[10], pc[11], pc[12], pl[10], pl[11], pl[12], lp, row, col, with_ctx)
    xl = xl + g1 * merge_branches((yl_a, yl_b, yl_c, yl_d), pl[13], lp)
    hl2 = None
    if with_ctx:
        xc = xc + cg1 * merge_branches((yc_a, yc_b, yc_c, yc_d), pc[13], lp)
        hl2 = rms_norm(xl, lp['norm2']) * (1 + sc2) + sh2
        hc2 = rms_norm(xc, lp['norm2']) * (1 + csc2) + csh2
        f = hier_moe(jnp.concatenate([hc2.reshape(-1, D), hl2.reshape(-1, D)], axis=0), lp)
        xc = xc + cg2 * f[:bsz * C].reshape(xc.shape)
        xl = xl + g2 * f[bsz * C:].reshape(xl.shape)
        return xl, xc
    hl2 = rms_norm(xl, lp['norm2']) * (1 + sc2) + sh2
    xl = xl + g2 * hier_moe(hl2.reshape(-1, D), lp).reshape(xl.shape)
    return xl, None


def setup_inputs(seed: int = 0) -> dict:
    key = jax.random.key(seed)
    ks = jax.random.split(key, 40)
    D, Ld = D_MODEL, DEPTH
    nrm = lambda i, shape, s: jax.random.normal(ks[i], shape, jnp.float32) * s
    uni = lambda i, shape, lo, hi: jax.random.uniform(ks[i], shape, jnp.float32, lo, hi)
    dt0 = jnp.exp(uni(11, (Ld, 2, SSD_HEADS), math.log(1e-3), math.log(1e-1)))
    a_c = uni(24, (Ld, 2, LRU_W), 0.9, 0.999) ** (1.0 / LRU_C)
    return {
        'x': nrm(0, (BATCH, SEQ, D), 1.0),
        'c': nrm(1, (BATCH, D), 1.0),
        'ctx': nrm(2, (BATCH, CTX_LEN, D), 1.0),
        'c_ctx': nrm(3, (D,), 1.0),
        'ada_w': nrm(4, (Ld, D, 6 * D), 0.5 * D ** -0.5),
        'ada_b': nrm(5, (Ld, 6 * D), 0.02),
        'norm1': 1.0 + nrm(6, (Ld, D), 0.02),
        'norm2': 1.0 + nrm(7, (Ld, D), 0.02),
        'w_in': nrm(8, (Ld, D, IN_WIDTH), D ** -0.5),
        'ssd_conv_w': nrm(9, (Ld, CONV_W, SSD_XBC), CONV_W ** -0.5),
        'ssd_conv_b': nrm(10, (Ld, SSD_XBC), 0.02),
        'ssd_dt_bias': dt0 + jnp.log(-jnp.expm1(-dt0)),
        'ssd_a_log': jnp.log(uni(12, (Ld, 2, SSD_HEADS), 1.0, 16.0)),
        'ssd_d': 1.0 + nrm(13, (Ld, SSD_HEADS), 0.1),
        'ssd_norm': 1.0 + nrm(14, (Ld, SSD_INNER), 0.02),
        'gla_g2': nrm(15, (Ld, 2, GLA_RANK, GLA_HEADS * GLA_DK), GLA_RANK ** -0.5),
        'gla_gb': nrm(16, (Ld, 2, GLA_HEADS * GLA_DK), 0.1),
        'gla_norm': 1.0 + nrm(17, (Ld, GLA_HEADS * GLA_DV), 0.02),
        'lru_conv_w': nrm(18, (Ld, CONV_W, LRU_W), CONV_W ** -0.5),
        'lru_conv_b': nrm(19, (Ld, LRU_W), 0.02),
        'lru_wa': nrm(20, (Ld, 2, LRU_BLOCKS, LRU_BLOCK, LRU_BLOCK), LRU_BLOCK ** -0.5),
        'lru_ba': nrm(21, (Ld, 2, LRU_W), 0.02),
        'lru_wx': nrm(22, (Ld, 2, LRU_BLOCKS, LRU_BLOCK, LRU_BLOCK), LRU_BLOCK ** -0.5),
        'lru_bx': nrm(23, (Ld, 2, LRU_W), 0.02),
        'lru_lambda': jnp.log(a_c) - jnp.log1p(-a_c),
        'att_qnorm': 1.0 + nrm(25, (Ld, ATT_HEAD_DIM), 0.02),
        'att_knorm': 1.0 + nrm(26, (Ld, ATT_HEAD_DIM), 0.02),
        'w_branch': nrm(27, (Ld, N_BRANCH, BRANCH_W, D), BRANCH_W ** -0.5),
        'w_out': nrm(28, (Ld, D, D), D ** -0.5),
        'router_wg': nrm(29, (Ld, D, MOE_GROUPS), D ** -0.5),
        'router_bg': nrm(30, (Ld, MOE_GROUPS), 0.01),
        'router_we': nrm(31, (Ld, D, MOE_EXPERTS), D ** -0.5),
        'router_be': nrm(32, (Ld, MOE_EXPERTS), 0.01),
        'exp_w1': nrm(33, (Ld, MOE_EXPERTS, D, MOE_FF), D ** -0.5),
        'exp_w3': nrm(34, (Ld, MOE_EXPERTS, D, MOE_FF), D ** -0.5),
        'exp_w2': nrm(35, (Ld, MOE_EXPERTS, MOE_FF, D), MOE_FF ** -0.5),
    }


def reference(x, c, ctx, c_ctx, ada_w, ada_b, norm1, norm2, w_in, ssd_conv_w, ssd_conv_b, ssd_dt_bias,
              ssd_a_log, ssd_d, ssd_norm, gla_g2, gla_gb, gla_norm, lru_conv_w, lru_conv_b, lru_wa, lru_ba,
              lru_wx, lru_bx, lru_lambda, att_qnorm, att_knorm, w_branch, w_out, router_wg, router_bg,
              router_we, router_be, exp_w1, exp_w3, exp_w2):
    L = x.shape[1]
    rows = L // GRID_W
    row = jnp.repeat(jnp.arange(rows, dtype=jnp.int32), GRID_W)
    col = jnp.tile(jnp.arange(GRID_W, dtype=jnp.int32), rows)
    xl, xc = x, ctx
    for l in range(DEPTH):
        lp = dict(norm1=norm1[l], norm2=norm2[l], w_in=w_in[l],
                  ssd_conv_w=ssd_conv_w[l], ssd_conv_b=ssd_conv_b[l], ssd_dt_bias=ssd_dt_bias[l],
                  ssd_a_log=ssd_a_log[l], ssd_d=ssd_d[l], ssd_norm=ssd_norm[l],
                  gla_g2=gla_g2[l], gla_gb=gla_gb[l], gla_norm=gla_norm[l],
                  lru_conv_w=lru_conv_w[l], lru_conv_b=lru_conv_b[l], lru_wa=lru_wa[l], lru_ba=lru_ba[l],
                  lru_wx=lru_wx[l], lru_bx=lru_bx[l], lru_lambda=lru_lambda[l],
                  att_qnorm=att_qnorm[l], att_knorm=att_knorm[l], w_branch=w_branch[l], w_out=w_out[l],
                  router_wg=router_wg[l], router_bg=router_bg[l], router_we=router_we[l],
                  router_be=router_be[l], exp_w1=exp_w1[l], exp_w3=exp_w3[l], exp_w2=exp_w2[l])
        mod_l = jax.nn.silu(c) @ ada_w[l] + ada_b[l]
        mod_c = jax.nn.silu(c_ctx) @ ada_w[l] + ada_b[l]
        xl, xc = hybrid_layer(xl, xc, mod_l, mod_c, lp, row, col, l < DEPTH - 1)
    return xl
```

```cpp
#include <hip/hip_runtime.h>
#include <stdint.h>
#include <stdio.h>

#ifndef MK_ONE_LAUNCH
#define MK_ONE_LAUNCH 1
#endif

typedef unsigned short bf16_t;
typedef short bf16x8 __attribute__((ext_vector_type(8)));
typedef short s16x4 __attribute__((ext_vector_type(4)));
typedef float f32x4 __attribute__((ext_vector_type(4)));
typedef float f32x16 __attribute__((ext_vector_type(16)));
typedef unsigned u32x4 __attribute__((ext_vector_type(4)));
typedef unsigned u32x2 __attribute__((ext_vector_type(2)));

constexpr int D = 1024, NB = 4, LAT = 4096, CTX = 256, SEQ = CTX + LAT, T = NB * SEQ;
constexpr int INW = 9776;
constexpr int NTHREADS = 512;
constexpr float EPS = 1e-6f;

constexpr size_t U = (size_t)T * 256 * 2;
constexpr size_t WS_Z = 0, WS_GR = 2 * U, WS_LG = 4 * U, WS_AQ = 6 * U, WS_GV = 8 * U, WS_LX = 10 * U, WS_AK = 12 * U, WS_AV = 13 * U,
                 WS_XBC = 14 * U, WS_GQ = 18 * U, WS_GK = 20 * U, WS_TMP = 22 * U, WS_H = 30 * U, WS_ACT_END = 34 * U;
constexpr size_t WS_GATES = 14 * U;
constexpr size_t WS_MOEA = 14 * U;
constexpr size_t WS_MOEO = 0;
constexpr size_t WS_XBCC = WS_TMP, WS_G = WS_TMP + 4 * U;
constexpr size_t WS_HF = WS_H, WS_HB = WS_H + 2 * U;
constexpr size_t WS_YS = WS_H, WS_OS = WS_H + 2 * U;
constexpr size_t WS_SST = WS_XBC;
constexpr size_t WS_WIN = WS_ACT_END;
constexpr int    NWIN = 9984;
constexpr size_t WS_WB = WS_WIN + (size_t)NWIN * 1024 * 2;
constexpr size_t WS_WO = WS_WB + (size_t)4 * 1024 * 512 * 2;
constexpr size_t WS_E13 = WS_WO + (size_t)1024 * 1024 * 2;
constexpr size_t WS_E2 = WS_E13 + (size_t)16 * 1024 * 1024 * 2;
constexpr size_t WS_GST0 = WS_TMP + 4 * U, WS_GST1 = WS_E13;
static_assert(WS_E2 + (size_t)16 * 1024 * 512 * 2 - WS_E13 >= 4 * U, "gla dir-1 states must fit the expert weight region");
constexpr size_t WS_SM = WS_E2 + (size_t)16 * 1024 * 512 * 2;
constexpr size_t WS_DTV = WS_SM + (size_t)T * 48 * 4;
constexpr size_t WS_XC = WS_DTV + (size_t)T * 16 * 4;
constexpr size_t WS_MOD = WS_XC + (size_t)NB * CTX * 1024 * 4;
constexpr int    MAXSLOT = 2 * T + 16 * 256;
constexpr size_t WS_TOKE = WS_MOD + (size_t)2 * 5 * 6144 * 4;
constexpr size_t WS_TOKP = WS_TOKE + (size_t)T * 2 * 4;
constexpr size_t WS_TOKW = WS_TOKP + (size_t)T * 2 * 4;
constexpr size_t WS_LIST = WS_TOKW + (size_t)T * 2 * 4;
constexpr size_t WS_CNT = WS_LIST + (size_t)16 * T * 4;
constexpr size_t WS_SSQ = WS_CNT + 256;
constexpr size_t WS_CD = WS_SSQ + (size_t)T * 2 * 4;
constexpr size_t WS_GTOT = WS_CD + (size_t)NB * 2 * 34 * 8 * 4 + 128;
constexpr size_t WS_LSUM = WS_GTOT + (size_t)NB * 2 * 68 * 4 * 128 * 4;
constexpr size_t WS_G2T = WS_LSUM + (size_t)NB * 2 * 34 * 512 * 2 * 4;
constexpr size_t WS_CTL = WS_G2T + 2 * 512 * 16 * 2;
constexpr size_t WS_GE = WS_CTL + 16384;
constexpr size_t WS_END = WS_GE + 3 * U;

#define XB_TMO      128
#define XB_XCNT(j)  (256  + 64 * (j))
#define XB_XSUB(j)  (1280 + 64 * (j))
#define XB_XGEN(j)  (2304 + 64 * (j))
#define XB_TOP      3328
#define XB_TOPGEN   3392
#define XCD_BAR_WORDS 3456
#define XB_SPIN_CAP (1u << 24)
#define LAS __attribute__((address_space(3)))

__device__ __forceinline__ unsigned xb_ld(unsigned* p)              { return __hip_atomic_load(p, __ATOMIC_RELAXED, __HIP_MEMORY_SCOPE_AGENT); }
__device__ __forceinline__ unsigned xb_add(unsigned* p, unsigned v) { return __hip_atomic_fetch_add(p, v, __ATOMIC_RELAXED, __HIP_MEMORY_SCOPE_AGENT); }
__device__ __forceinline__ unsigned xb_xcc_id() { return (unsigned)__builtin_amdgcn_s_getreg((3 << 11) | 20) & 0xFu; }
#define XB_SPIN(cond, bar) do { unsigned _sp = 0; while (cond) { __builtin_amdgcn_s_sleep(1); \
    if ((++_sp & 255u) == 0u) { if (xb_ld(&(bar)[XB_TMO])) break; if (_sp > XB_SPIN_CAP) { atomicAdd(&(bar)[XB_TMO], 1u); break; } } } } while (0)

struct XcdBarrier { unsigned* bar; unsigned x; volatile LAS unsigned* st; };
__device__ __forceinline__ bool xb_tid0();

__device__ __forceinline__ XcdBarrier xcd_barrier_post(unsigned* bar, volatile LAS unsigned* st) {
    XcdBarrier b; b.bar = bar; b.x = xb_xcc_id(); b.st = st;
    if (xb_tid0()) (void)xb_add(&bar[XB_XCNT(b.x)], 1u);
    return b;
}
__device__ __forceinline__ void xcd_barrier_complete(unsigned* bar, unsigned x, unsigned& nloc, unsigned& nx) {
    const unsigned G = gridDim.x * gridDim.y * gridDim.z;
    unsigned sum, cnt, mine, sp = 0u;
    for (;;) {
        sum = 0u; cnt = 0u; mine = 0u;
#pragma unroll
        for (unsigned j = 0; j < 16; ++j) { const unsigned c = xb_ld(&bar[XB_XCNT(j)]); sum += c; cnt += (c > 0u) ? 1u : 0u; mine = (j == x) ? c : mine; }
        if (sum == G) break;
        __builtin_amdgcn_s_sleep(1);
        if ((++sp & 255u) == 0u) { if (xb_ld(&bar[XB_TMO])) break; if (sp > XB_SPIN_CAP) { atomicAdd(&bar[XB_TMO], 1u); break; } }
    }
    nloc = mine > 0u ? mine : 1u; nx = cnt > 0u ? cnt : 1u;
}
__device__ __forceinline__ void xcd_barrier(const XcdBarrier& b) {
    asm volatile("s_waitcnt vmcnt(0)" ::: "memory");
    __syncthreads();
    if (xb_tid0()) {
        unsigned* bar = b.bar;
        __builtin_amdgcn_s_waitcnt(0);
        unsigned nloc = b.st[0], nx = b.st[1];
        if (nloc == 0u) { xcd_barrier_complete(bar, b.x, nloc, nx); b.st[0] = nloc; b.st[1] = nx; }
        const unsigned old = xb_add(&bar[XB_XSUB(b.x)], 1u);
        const unsigned gen = old / nloc;
        if (old + 1u == (gen + 1u) * nloc) {
            __builtin_amdgcn_fence(__ATOMIC_RELEASE, "agent");
            asm volatile("s_waitcnt vmcnt(0)" ::: "memory");
            (void)xb_add(&bar[XB_TOP], 1u);
        }
        __builtin_amdgcn_fence(__ATOMIC_ACQUIRE, "agent");
        XB_SPIN(xb_ld(&bar[XB_TOP]) < (gen + 1u) * nx, bar);
        asm volatile("s_waitcnt vmcnt(0)" ::: "memory");
    }
    __syncthreads();
}

constexpr int LDS_MAIN = 131072;
struct Args { const float* in[36]; float* out; unsigned char* ws; int ph_lo, ph_hi; };
typedef const Args __attribute__((address_space(4)))* KArgs;
__device__ __forceinline__ KArgs kargs() { KArgs p = (KArgs)__builtin_amdgcn_kernarg_segment_ptr(); asm volatile("" : "+s"(p)); return p; }

constexpr int LDS_WTAB = LDS_MAIN + 12032;
__device__ __forceinline__ unsigned hw_slot() { return (unsigned)__builtin_amdgcn_s_getreg((5 << 11) | 4) & 63u; }
__device__ __forceinline__ int ltid() {
    extern __shared__ __attribute__((aligned(16))) char shm_[];
    const int w = *(volatile int*)(shm_ + LDS_WTAB + 4 * hw_slot());
    int lane; asm volatile("v_mbcnt_lo_u32_b32 %0, -1, 0\n\tv_mbcnt_hi_u32_b32 %0, -1, %0" : "=v"(lane));
    return (__builtin_amdgcn_readfirstlane(w) << 6) | lane;
}
__device__ __forceinline__ bool xb_tid0() { return ltid() == 0; }
__device__ __forceinline__ float bf2f(bf16_t v) { return __uint_as_float(((unsigned)v) << 16); }
__device__ __forceinline__ bf16_t f2bf(float f) { unsigned u = __float_as_uint(f); u += 0x7fffu + ((u >> 16) & 1u); return (bf16_t)(u >> 16); }
typedef float f32x2_t __attribute__((ext_vector_type(2)));
typedef __bf16 bf16x2_t __attribute__((ext_vector_type(2)));
__device__ __forceinline__ unsigned cvtpk(float lo, float hi) { const f32x2_t v = {lo, hi}; const bf16x2_t b = __builtin_convertvector(v, bf16x2_t); return __builtin_bit_cast(unsigned, b); }
__device__ __forceinline__ unsigned cvtpk_asm(float lo, float hi) { unsigned r; asm volatile("v_cvt_pk_bf16_f32 %0, %1, %2" : "=v"(r) : "v"(lo), "v"(hi)); return r; }
__device__ __forceinline__ u32x4 pair16(u32x2 A, u32x2 B) {
    const auto rx = __builtin_amdgcn_permlane32_swap(A[0], B[0], false, false); const auto ry = __builtin_amdgcn_permlane32_swap(A[1], B[1], false, false);
    return (u32x4){rx[0], ry[0], rx[1], ry[1]}; }
__device__ __forceinline__ float lo_bf(unsigned w) { return __uint_as_float(w << 16); }
__device__ __forceinline__ float hi_bf(unsigned w) { return __uint_as_float(w & 0xffff0000u); }
__device__ __forceinline__ float sigmoidf_(float x) { return __builtin_amdgcn_rcpf(1.f + __expf(-x)); }
__device__ __forceinline__ float siluf_(float x) { return x * __builtin_amdgcn_rcpf(1.f + __expf(-x)); }
__device__ __forceinline__ float softplusf_(float x) { return x > 20.f ? x : log1pf(__expf(x)); }
__device__ __forceinline__ float softplus_rel(float x) { if (x > 15.f) return x; const float e = __expf(x); return e < 0.06f ? e * (1.f - e * (0.5f - e * (0.33333334f - e * (0.25f - e * 0.2f)))) : __logf(1.f + e); }
__device__ __forceinline__ float softplus_fast(float x) { return x > 15.f ? x : __logf(1.f + __expf(x)); }
__device__ __forceinline__ float tanh_fast(float x) { const float e = __expf(2.f * x); return 1.f - 2.f * __builtin_amdgcn_rcpf(e + 1.f); }
__device__ __forceinline__ float gelu_tanh(float x) { const float u = 0.7978845608028654f * (x + 0.044715f * x * x * x); return 0.5f * x * (1.f + tanh_fast(u)); }
__device__ __forceinline__ float wave_sum(float v) {
#pragma unroll
    for (int o = 32; o >= 1; o >>= 1) v += __shfl_xor(v, o, 64);
    return v;
}
__device__ __forceinline__ float* xrow(KArgs a, int row) {
    const int b = row / SEQ, pos = row - b * SEQ;
    return pos < CTX ? (float*)(a->ws + WS_XC) + (size_t)(b * CTX + pos) * D : a->out + (size_t)(b * LAT + pos - CTX) * D;
}
__device__ __forceinline__ const float* xrow_in(KArgs a, int row) {
    const int b = row / SEQ, pos = row - b * SEQ;
    return pos < CTX ? a->in[2] + (size_t)(b * CTX + pos) * D : a->in[0] + (size_t)(b * LAT + pos - CTX) * D;
}
__device__ __forceinline__ const float* modp(KArgs a, int l, int row, int chunk) {
    const int b = row / SEQ, pos = row - b * SEQ; const int j = pos < CTX ? 4 : b;
    return (const float*)(a->ws + WS_MOD) + ((size_t)(l * 5 + j) * 6 + chunk) * 1024;
}

constexpr int BM = 256, BK = 64, HALF = 128, HT = HALF * BK;
__device__ __forceinline__ int lds_byte(int r, int c) { int st = (r >> 4) * 2 + (c >> 5), rr = r & 15, cc = c & 31, ob = rr * 64 + cc * 2; return st * 1024 + (ob ^ (((ob >> 9) & 1) << 5)); }
__device__ __forceinline__ void stage_rc(int b, int& R, int& C) { int st = b / 1024, sb = b % 1024, swz = sb ^ (((sb >> 9) & 1) << 5); R = (st >> 1) * 16 + swz / 64; C = (st & 1) * 32 + (swz % 64) / 2; }

struct AMapId { int base; int K; __device__ __forceinline__ unsigned voff(int) const { return (unsigned)base * 2u; } __device__ __forceinline__ size_t soff(int q) const { return (size_t)q * 64 * K * 2; } };
struct AMapG  { int o[4]; __device__ __forceinline__ unsigned voff(int q) const { return (unsigned)o[q] * 2u; } __device__ __forceinline__ size_t soff(int) const { return 0; } };
__device__ __forceinline__ void glds16(const void* sbase, unsigned voff, unsigned lds_dst) {
    unsigned keep;
    asm volatile("s_mov_b32 %0, m0\n\ts_mov_b32 m0, %3\n\ts_nop 0\n\tglobal_load_lds_dwordx4 %1, %2\n\ts_mov_b32 m0, %0" : "=&s"(keep) : "v"(voff), "s"(sbase), "s"(lds_dst) : "memory");
}

template <class AM>
__device__ __forceinline__ void gemm_tile(const bf16_t* __restrict__ A, const bf16_t* __restrict__ Bt, const int K, const AM am, const int bbase  ,
                                          f32x4 (&acc)[2][2][4][2], char* shmc) {
    bf16_t* shm = (bf16_t*)shmc;
#define SA(b,h) (shm+((b)*2+(h))*HT)
#define SB(b,h) (shm+(4+(b)*2+(h))*HT)
#define STAGE_A(P,h,kt) do{ for(int _i=0;_i<2;++_i){ \
      glds16((const char*)(A+(kt)*BK)+am.soff((h)*2+_i), am.voff((h)*2+_i), lbase+(unsigned)((const char*)(P)-shmc)+wvu*1024u+_i*8192u);} }while(0)
#define STAGE_B(P,h,kt) do{ for(int _i=0;_i<2;++_i){ \
      glds16((const char*)(Bt+((h)*2+_i)*64*K+(kt)*BK), bboff, lbase+(unsigned)((const char*)(P)-shmc)+wvu*1024u+_i*8192u);} }while(0)
#define LDA(dst,b,h) for(int m=0;m<4;++m)for(int k=0;k<2;++k) \
    dst[m][k]=*reinterpret_cast<const bf16x8*>(shmc+laA+(((b)*2+(h))*HT*2+m*2048+k*1024))
#define LDB(dst,b,h) for(int n=0;n<2;++n)for(int k=0;k<2;++k) \
    dst[n][k]=*reinterpret_cast<const bf16x8*>(shmc+laB+(((b)*2+(h))*HT*2+n*2048+k*1024))
#define MMA(ai,bj,At,Bx) do{__builtin_amdgcn_s_setprio(1); \
    for(int m=0;m<4;++m)for(int n=0;n<2;++n)for(int k=0;k<2;++k) \
      acc[ai][bj][m][n]=__builtin_amdgcn_mfma_f32_16x16x32_bf16(Bx[n][k],At[m][k],acc[ai][bj][m][n],0,0,0); \
    __builtin_amdgcn_s_setprio(0);}while(0)
#define WAIT_V(n) asm volatile("s_waitcnt vmcnt(" #n ")":::"memory")
#define WAIT_L(n) asm volatile("s_waitcnt lgkmcnt(" #n ")":::"memory")
#define BAR __builtin_amdgcn_s_barrier()
#define SCHED __builtin_amdgcn_sched_barrier(0)
    int tz = ltid();
    const unsigned bboff = (unsigned)bbase * 2u;
    const unsigned lbase = (unsigned)(uintptr_t)shmc;
    const int wid = tz >> 6, lane = tz & 63, wr = wid >> 2, wc = wid & 3, fr = lane & 15, fq = lane >> 4;
    const unsigned wvu = (unsigned)__builtin_amdgcn_readfirstlane(wid);
    const int laA = lds_byte(wr * 64 + fr, fq * 8), laB = 4 * HT * 2 + lds_byte(wc * 32 + fr, fq * 8);
#pragma unroll
    for (int ai = 0; ai < 2; ++ai)
#pragma unroll
        for (int bj = 0; bj < 2; ++bj)
#pragma unroll
            for (int m = 0; m < 4; ++m)
#pragma unroll
                for (int n = 0; n < 2; ++n) acc[ai][bj][m][n] = (f32x4){0.f, 0.f, 0.f, 0.f};
    bf16x8 At[4][2], B0[2][2], B1[2][2];
    const int nt = K / BK;
    STAGE_B(SB(0,0),0,0); STAGE_A(SA(0,0),0,0);
    STAGE_B(SB(0,1),1,0); STAGE_A(SA(0,1),1,0);
    if (wr == 1) BAR;
    WAIT_V(4); BAR;
    STAGE_B(SB(1,0),0,1); STAGE_A(SA(1,0),0,1); STAGE_B(SB(1,1),1,1);
    WAIT_V(6); BAR;
    for (int t = 0; t < nt - 2; t += 2) {
        LDB(B0,0,0); SCHED; LDA(At,0,0); STAGE_A(SA(1,1),1,t+1);
        WAIT_L(8); BAR; WAIT_L(0); MMA(0,0,At,B0); BAR; SCHED;
        LDB(B1,0,1); STAGE_B(SB(0,0),0,t+2);
        BAR; WAIT_L(0); MMA(0,1,At,B1); BAR;
        LDA(At,0,1); STAGE_A(SA(0,0),0,t+2);
        BAR; WAIT_L(0); MMA(1,0,At,B0); BAR; SCHED;
        STAGE_B(SB(0,1),1,t+2);
        WAIT_V(6); BAR; MMA(1,1,At,B1); BAR;
        LDB(B0,1,0); SCHED; LDA(At,1,0); STAGE_A(SA(0,1),1,t+2);
        WAIT_L(8); BAR; WAIT_L(0); MMA(0,0,At,B0); BAR; SCHED;
        LDB(B1,1,1); STAGE_B(SB(1,0),0,t+3);
        BAR; WAIT_L(0); MMA(0,1,At,B1); BAR;
        LDA(At,1,1); STAGE_A(SA(1,0),0,t+3);
        BAR; WAIT_L(0); MMA(1,0,At,B0); BAR; SCHED;
        STAGE_B(SB(1,1),1,t+3);
        WAIT_V(6); BAR; MMA(1,1,At,B1); BAR;
    }
    { LDB(B0,0,0); WAIT_V(0); LDA(At,0,0); STAGE_A(SA(1,1),1,nt-1);
      BAR; WAIT_L(0); MMA(0,0,At,B0); BAR;
      LDB(B1,0,1); BAR; WAIT_L(0); MMA(0,1,At,B1); BAR;
      LDA(At,0,1); WAIT_V(4); BAR; WAIT_L(0); MMA(1,0,At,B0); MMA(1,1,At,B1); BAR; }
    { LDB(B0,1,0); LDA(At,1,0); WAIT_V(2); BAR; WAIT_L(0); MMA(0,0,At,B0); BAR;
      LDB(B1,1,1); WAIT_V(0); BAR; WAIT_L(0); MMA(0,1,At,B1); BAR;
      LDA(At,1,1); BAR; WAIT_L(0); MMA(1,0,At,B0); MMA(1,1,At,B1); BAR; }
    if (wr == 0) BAR;
    asm volatile("" ::: "memory");
#undef SA
#undef SB
#undef STAGE_A
#undef STAGE_B
#undef LDA
#undef LDB
#undef MMA
}
template <class AM, class DescF, class EpiF>
__device__ __forceinline__ void gemm_stream(const int K, const int ntl, DescF desc, EpiF epi, char* shmc) {
    if (ntl <= 0) return;
    bf16_t* shm = (bf16_t*)shmc;
#define SA(b,h) (shm+((b)*2+(h))*HT)
#define SB(b,h) (shm+(4+(b)*2+(h))*HT)
#ifndef WAIT_V
#define WAIT_V(n) asm volatile("s_waitcnt vmcnt(" #n ")":::"memory")
#define WAIT_L(n) asm volatile("s_waitcnt lgkmcnt(" #n ")":::"memory")
#define BAR __builtin_amdgcn_s_barrier()
#define SCHED __builtin_amdgcn_sched_barrier(0)
#endif
#define XSTAGE_A(P,h,DA,DM,kt) do{ for(int _i=0;_i<2;++_i){ \
      glds16((const char*)((DA)+(kt)*BK)+(DM).soff((h)*2+_i), (DM).voff((h)*2+_i), lbase+(unsigned)((const char*)(P)-shmc)+wvu*1024u+_i*8192u);} }while(0)
#define XSTAGE_B(P,h,DB,DO,kt) do{ for(int _i=0;_i<2;++_i){ \
      glds16((const char*)((DB)+((h)*2+_i)*64*K+(kt)*BK), (DO), lbase+(unsigned)((const char*)(P)-shmc)+wvu*1024u+_i*8192u);} }while(0)
#define LDA(dst,b,h) for(int m=0;m<4;++m)for(int k=0;k<2;++k) \
    dst[m][k]=*reinterpret_cast<const bf16x8*>(shmc+laA+(((b)*2+(h))*HT*2+m*2048+k*1024))
#define LDB(dst,b,h) for(int n=0;n<2;++n)for(int k=0;k<2;++k) \
    dst[n][k]=*reinterpret_cast<const bf16x8*>(shmc+laB+(((b)*2+(h))*HT*2+n*2048+k*1024))
#define MMA(ai,bj,At,Bx) do{__builtin_amdgcn_s_setprio(1); \
    for(int m=0;m<4;++m)for(int n=0;n<2;++n)for(int k=0;k<2;++k) \
      acc[ai][bj][m][n]=__builtin_amdgcn_mfma_f32_16x16x32_bf16(Bx[n][k],At[m][k],acc[ai][bj][m][n],0,0,0); \
    __builtin_amdgcn_s_setprio(0);}while(0)
    const int tz = ltid();
    const unsigned lbase = (unsigned)(uintptr_t)shmc;
    const int wid = tz >> 6, lane = tz & 63, wr = wid >> 2, wc = wid & 3, fr = lane & 15, fq = lane >> 4;
    const unsigned wvu = (unsigned)__builtin_amdgcn_readfirstlane(wid);
    const int laA = lds_byte(wr * 64 + fr, fq * 8), laB = 4 * HT * 2 + lds_byte(wc * 32 + fr, fq * 8);
    const int nt = K / BK;
    const bf16_t* cA; const bf16_t* cB; AM cM; unsigned cO;
    const bf16_t* nA; const bf16_t* nB; AM nM; unsigned nO;
    desc(0, cA, cB, cM, cO);
    XSTAGE_B(SB(0,0),0,cB,cO,0); XSTAGE_A(SA(0,0),0,cA,cM,0);
    XSTAGE_B(SB(0,1),1,cB,cO,0); XSTAGE_A(SA(0,1),1,cA,cM,0);
    if (wr == 1) BAR;
    WAIT_V(4); BAR;
    XSTAGE_B(SB(1,0),0,cB,cO,1); XSTAGE_A(SA(1,0),0,cA,cM,1); XSTAGE_B(SB(1,1),1,cB,cO,1);
    WAIT_V(6); BAR;
    for (int kt = 0; kt < ntl; ++kt) {
        if (kt + 1 < ntl) desc(kt + 1, nA, nB, nM, nO); else { nA = cA; nB = cB; nM = cM; nO = cO; }
        f32x4 acc[2][2][4][2];
#pragma unroll
        for (int ai = 0; ai < 2; ++ai)
#pragma unroll
            for (int bj = 0; bj < 2; ++bj)
#pragma unroll
                for (int m = 0; m < 4; ++m)
#pragma unroll
                    for (int n = 0; n < 2; ++n) acc[ai][bj][m][n] = (f32x4){0.f, 0.f, 0.f, 0.f};
        bf16x8 At[4][2], B0[2][2], B1[2][2];
        for (int t = 0; t < nt; t += 2) {
            const bool last = t + 2 >= nt;
            const bf16_t* sA = last ? nA : cA; const bf16_t* sB = last ? nB : cB; const unsigned sO = last ? nO : cO; const int k2 = last ? 0 : t + 2, k3 = last ? 1 : t + 3;
            AM sM = cM; if (last) sM = nM;
            LDB(B0,0,0); SCHED; LDA(At,0,0); XSTAGE_A(SA(1,1),1,cA,cM,t+1);
            WAIT_L(8); BAR; WAIT_L(0); MMA(0,0,At,B0); BAR; SCHED;
            LDB(B1,0,1); XSTAGE_B(SB(0,0),0,sB,sO,k2);
            BAR; WAIT_L(0); MMA(0,1,At,B1); BAR;
            LDA(At,0,1); XSTAGE_A(SA(0,0),0,sA,sM,k2);
            BAR; WAIT_L(0); MMA(1,0,At,B0); BAR; SCHED;
            XSTAGE_B(SB(0,1),1,sB,sO,k2);
            WAIT_V(6); BAR; MMA(1,1,At,B1); BAR;
            LDB(B0,1,0); SCHED; LDA(At,1,0); XSTAGE_A(SA(0,1),1,sA,sM,k2);
            WAIT_L(8); BAR; WAIT_L(0); MMA(0,0,At,B0); BAR; SCHED;
            LDB(B1,1,1); XSTAGE_B(SB(1,0),0,sB,sO,k3);
            BAR; WAIT_L(0); MMA(0,1,At,B1); BAR;
            LDA(At,1,1); XSTAGE_A(SA(1,0),0,sA,sM,k3);
            BAR; WAIT_L(0); MMA(1,0,At,B0); BAR; SCHED;
            XSTAGE_B(SB(1,1),1,sB,sO,k3);
            WAIT_V(6); BAR; MMA(1,1,At,B1); BAR;
        }
        if (kt + 1 == ntl) { WAIT_V(0); if (wr == 0) BAR; }
        asm volatile("" ::: "memory");
        epi(kt, acc);
        cA = nA; cB = nB; cM = nM; cO = nO;
    }
#undef XSTAGE_A
#undef XSTAGE_B
#undef LDA
#undef LDB
#undef MMA
#undef SA
#undef SB
}
#define EPI_LANES int tz_ = ltid(); const int wid = tz_ >> 6, lane = tz_ & 63, wr = wid >> 2, wc = wid & 3, fr = lane & 15, fq = lane >> 4
__device__ __forceinline__ void stage_coords(int& R0, int& C0) { stage_rc(ltid() * 16, R0, C0); }
__device__ __forceinline__ int xcd_unit(int k, int nu) { const int G = gridDim.x, bx = blockIdx.x;
    if ((G & 7) == 0 && (k + 1) * G <= nu) return k * G + (bx & 7) * (G >> 3) + (bx >> 3);
    return k * G + bx; }
__device__ __forceinline__ int bperm(int r) { return (r & ~31) | (((r >> 2) & 3) << 3) | (((r >> 4) & 1) << 2) | (r & 3); }

__device__ __forceinline__ int n_row_tiles(int l) { return l == 0 ? 68 : 64; }
__device__ __forceinline__ int row_tile_base(int l, int i) { return l == 0 ? i * 256 : ((i >> 4) * 17 + 1 + (i & 15)) * 256; }

__device__ __forceinline__ void ph_mod(KArgs a, char* shm) {
    float* s = (float*)shm;
    float* red = s + 5 * 1024;
    const int tid = ltid();
    if (blockIdx.x == 0 && tid < 64) ((int*)(a->ws + WS_CNT))[tid] = 0;
    for (int i = tid; i < 5 * 1024; i += NTHREADS) { const int j = i >> 10, k = i & 1023; const float c = j < 4 ? a->in[1][j * 1024 + k] : a->in[3][k]; s[i] = siluf_(c); }
    __syncthreads();
    const int cg = tid & 63, ks = tid >> 6;
    for (int u = blockIdx.x; u < 192; u += gridDim.x) {
        const int l = u / 96, c0 = (u % 96) * 64;
        const float* w = a->in[4] + (size_t)l * 1024 * 6144 + c0 + cg;
        float acc[5] = {0.f, 0.f, 0.f, 0.f, 0.f};
        for (int k = ks * 128; k < ks * 128 + 128; ++k) { const float wv = w[(size_t)k * 6144];
#pragma unroll
            for (int j = 0; j < 5; ++j) acc[j] += s[j * 1024 + k] * wv; }
#pragma unroll
        for (int j = 0; j < 5; ++j) red[(ks * 5 + j) * 64 + cg] = acc[j];
        __syncthreads();
        if (tid < 320) { const int j = tid >> 6; float v = a->in[5][l * 6144 + c0 + cg];
            for (int q = 0; q < 8; ++q) v += red[(q * 5 + j) * 64 + cg];
            ((float*)(a->ws + WS_MOD))[(size_t)(l * 5 + j) * 6144 + c0 + cg] = v; }
        __syncthreads();
    }
}

__device__ __forceinline__ int win_srccol(int r) {
    if (r < 512) return r;
    if (r < 1024) return 3120 + (r - 512);
    if (r < 1536) return 4144 + (r - 1024);
    if (r < 2048) return 4656 + (r - 1536);
    if (r < 2560) return 2576 + (r - 2048);
    if (r < 3072) return 3632 + (r - 2560);
    if (r < 3328) return 5168 + (r - 3072);
    if (r < 3584) return 5424 + (r - 3328);
    if (r < 4608) return 512 + (r - 3584);
    if (r < 5120) return 1552 + (r - 4608);
    if (r < 5632) return 2064 + (r - 5120);
    if (r < 5648) return 1536 + (r - 5632);
    if (r < 5680) return 3088 + (r - 5648);
    if (r < 5888) return -1;
    return 5680 + (r - 5888);
}
__device__ __forceinline__ void ph_cvt(KArgs a, int l, char* shm, int part, int fb = 0) {
    if ((int)blockIdx.x < fb) return;
    float* t = (float*)shm;
    const int tid = ltid();
    constexpr int N_WIN = (NWIN / 64) * 16, N_WB = 4 * 16 * 8, N_WO = 16 * 16, N_E13 = 16 * 16 * 16, N_E2 = 16 * 16 * 8;
    constexpr int NTOT = N_WIN + N_WB + N_WO + N_E13 + N_E2;
    const int bxe = blockIdx.x - fb, Ge = gridDim.x - fb;
    if (part == 0 || part == 2) { bf16_t* G2T = (bf16_t*)(a->ws + WS_G2T); for (int i = bxe * NTHREADS + tid; i < 2 * 512 * 16; i += Ge * NTHREADS) { const int d = i >> 13, k = (i >> 4) & 511, r = i & 15; G2T[i] = f2bf(a->in[15][((l * 2 + d) * 16 + r) * 512 + k]); } }
    constexpr int U1 = N_WIN + N_WB, U2 = U1 + N_WO, U3 = U2 + N_E13;
    const int ulo = part == 1 || part == 4 ? U2 : (part == 3 ? U1 : (part == 5 ? U3 : 0)), uhi = part == 1 || part == 5 ? NTOT : (part == 2 ? U1 : (part == 4 ? U3 : U2));
    for (int u = ulo + bxe; u < uhi; u += Ge) {
        const float* src; int ld, kind, n0, k0, K; bf16_t* dst; const float* src2 = nullptr;
        int v = u;
        if (v < N_WIN) { src = a->in[8] + (size_t)l * 1024 * INW; ld = INW; kind = 1; n0 = (v / 16) * 64; k0 = (v % 16) * 64; K = 1024; dst = (bf16_t*)(a->ws + WS_WIN); }
        else if ((v -= N_WIN) < N_WB) { const int n = v / 128, r = v % 128; src = a->in[27] + (size_t)(l * 4 + n) * 512 * 1024; ld = 1024; kind = 0; n0 = (r / 8) * 64; k0 = (r % 8) * 64; K = 512;
                                        dst = (bf16_t*)(a->ws + WS_WB) + (size_t)n * 1024 * 512; }
        else if ((v -= N_WB) < N_WO) { src = a->in[28] + (size_t)l * 1024 * 1024; ld = 1024; kind = 0; n0 = (v / 16) * 64; k0 = (v % 16) * 64; K = 1024; dst = (bf16_t*)(a->ws + WS_WO); }
        else if ((v -= N_WO) < N_E13) { const int e = v / 256, r = v % 256; src = a->in[33] + (size_t)(l * 16 + e) * 1024 * 512; src2 = a->in[34] + (size_t)(l * 16 + e) * 1024 * 512;
                                        ld = 512; kind = 2; n0 = (r / 16) * 64; k0 = (r % 16) * 64; K = 1024; dst = (bf16_t*)(a->ws + WS_E13) + (size_t)e * 1024 * 1024; }
        else { v -= N_E13; const int e = v / 128, r = v % 128; src = a->in[35] + (size_t)(l * 16 + e) * 512 * 1024; ld = 1024; kind = 0; n0 = (r / 8) * 64; k0 = (r % 8) * 64; K = 512;
               dst = (bf16_t*)(a->ws + WS_E2) + (size_t)e * 1024 * 512; }
        {   const int tx4 = tid & 15, ty = tid >> 4; const int n = n0 + tx4 * 4; int sc; const float* sp = src;
            if (kind == 0) sc = n; else if (kind == 1) sc = win_srccol(n); else { const int p = n & 255, w3 = (p >> 4) & 1; sc = (n >> 8) * 128 + ((p >> 5) & 3) * 32 + ((p >> 2) & 3) * 8 + (p >> 7) * 4; if (w3) sp = src2; }
#pragma unroll
            for (int i = 0; i < 2; ++i) { const int k = ty + 32 * i; const f32x4 v = sc >= 0 ? *(const f32x4*)(sp + (size_t)(k0 + k) * ld + sc) : (f32x4){0.f, 0.f, 0.f, 0.f};
                float* tp = t + k * 65 + tx4 * 4; tp[0] = v[0]; tp[1] = v[1]; tp[2] = v[2]; tp[3] = v[3]; }
        }
        __syncthreads();
        {   const int n = tid >> 3, ks = tid & 7;
            float v8[8];
#pragma unroll
            for (int j = 0; j < 8; ++j) v8[j] = t[(ks * 8 + j) * 65 + n];
            u32x4 w = {cvtpk(v8[0], v8[1]), cvtpk(v8[2], v8[3]), cvtpk(v8[4], v8[5]), cvtpk(v8[6], v8[7])};
            *(u32x4*)(dst + (size_t)(n0 + n) * K + k0 + ks * 8) = w;
        }
        __syncthreads();
    }
}

__device__ __forceinline__ void moe_offsets(KArgs a, int l, int* off);
__device__ __forceinline__ void moe_row(KArgs a, int l, int row, int lane, const int* off, f32x4 (&o)[4]);
__device__ __forceinline__ void ph_norm1(KArgs a, int l, char* shm, bool fuse) {
    int* off = (int*)(shm + LDS_MAIN + 16); if (fuse) moe_offsets(a, l - 1, off);
    const int tid = ltid(); const int lane = tid & 63, wv = tid >> 6;
    const float* g = a->in[6] + l * 1024;
    bf16_t* H = (bf16_t*)(a->ws + WS_H);
    const int* TE = (const int*)(a->ws + WS_TOKE); const int* TP = (const int*)(a->ws + WS_TOKP); const float* TW = (const float*)(a->ws + WS_TOKW);
    const bf16_t* MO = (const bf16_t*)(a->ws + WS_MOEO);
    const int step = gridDim.x * 8;
    int row = blockIdx.x * 8 + wv;
    f32x4 pv[4]; int pe0 = 0, pe1 = 0, pp0 = 0, pp1 = 0; float pw0 = 0.f, pw1 = 0.f;
    {   const int r = row < T ? row : 0; const float* x = l == 0 ? xrow_in(a, r) : (const float*)xrow(a, r);
#pragma unroll
        for (int i = 0; i < 4; ++i) pv[i] = *(const f32x4*)(x + i * 256 + lane * 4);
        if (fuse) { pe0 = TE[r * 2]; pe1 = TE[r * 2 + 1]; pp0 = TP[r * 2]; pp1 = TP[r * 2 + 1]; pw0 = TW[r * 2]; pw1 = TW[r * 2 + 1]; } }
    for (; row < T; row += step) {
        f32x4 v[4];
#pragma unroll
        for (int i = 0; i < 4; ++i) v[i] = pv[i];
        const int e0 = pe0, e1 = pe1, p0 = pp0, p1 = pp1; const float w0 = pw0, w1 = pw1;
        const float* sh = modp(a, l, row, 0); const float* sc = modp(a, l, row, 1);
        f32x4 gg[4], s1[4], s0[4];
#pragma unroll
        for (int i = 0; i < 4; ++i) { const int c = i * 256 + lane * 4; gg[i] = *(const f32x4*)(g + c); s1[i] = *(const f32x4*)(sc + c); s0[i] = *(const f32x4*)(sh + c); }
        u32x2 mp[4], mq[4]; f32x4 g2v[4];
#pragma unroll
        for (int i = 0; i < 4; ++i) { mp[i] = (u32x2){0u, 0u}; mq[i] = (u32x2){0u, 0u}; g2v[i] = (f32x4){0.f, 0.f, 0.f, 0.f}; }
        if (fuse) { const int sa = off[e0] + p0, sb = off[e1] + p1; const float* g2 = modp(a, l - 1, row, 5);
#pragma unroll
            for (int i = 0; i < 4; ++i) { const int c = i * 256 + lane * 4; mp[i] = *(const u32x2*)(MO + (size_t)sa * 1024 + c); mq[i] = *(const u32x2*)(MO + (size_t)sb * 1024 + c); g2v[i] = *(const f32x4*)(g2 + c); } }
        {   const int r = row + step < T ? row + step : row; const float* x = l == 0 ? xrow_in(a, r) : (const float*)xrow(a, r);
#pragma unroll
            for (int i = 0; i < 4; ++i) pv[i] = *(const f32x4*)(x + i * 256 + lane * 4);
            if (fuse) { pe0 = TE[r * 2]; pe1 = TE[r * 2 + 1]; pp0 = TP[r * 2]; pp1 = TP[r * 2 + 1]; pw0 = TW[r * 2]; pw1 = TW[r * 2 + 1]; } }
        __builtin_amdgcn_sched_barrier(0);
        if (fuse) { float* xw = xrow(a, row);
#pragma unroll
            for (int i = 0; i < 4; ++i) { const u32x2 p = mp[i], q = mq[i]; const f32x4 gq = g2v[i];
                v[i] += (f32x4){gq[0] * (w0 * lo_bf(p[0]) + w1 * lo_bf(q[0])), gq[1] * (w0 * hi_bf(p[0]) + w1 * hi_bf(q[0])), gq[2] * (w0 * lo_bf(p[1]) + w1 * lo_bf(q[1])), gq[3] * (w0 * hi_bf(p[1]) + w1 * hi_bf(q[1]))};
                *(f32x4*)(xw + i * 256 + lane * 4) = v[i]; } }
        float ss = 0.f;
#pragma unroll
        for (int i = 0; i < 4; ++i) ss += v[i][0] * v[i][0] + v[i][1] * v[i][1] + v[i][2] * v[i][2] + v[i][3] * v[i][3];
        ss = wave_sum(ss);
        const float inv = rsqrtf(ss * (1.f / 1024.f) + EPS);
#pragma unroll
        for (int i = 0; i < 4; ++i) { const int c = i * 256 + lane * 4;
            float o[4];
#pragma unroll
            for (int j = 0; j < 4; ++j) o[j] = v[i][j] * inv * gg[i][j] * (1.f + s1[i][j]) + s0[i][j];
            u32x2 w = {cvtpk(o[0], o[1]), cvtpk(o[2], o[3])};
            *(u32x2*)(H + (size_t)row * 1024 + c) = w; }
    }
}

constexpr int NGE = 3;
__device__ __forceinline__ void ph_gemm_in(KArgs a, int l, char* shm) {
    const bf16_t* H = (const bf16_t*)(a->ws + WS_H); const bf16_t* W = (const bf16_t*)(a->ws + WS_WIN);
    int R0, C0; stage_coords(R0, C0);
    const int nu = l == 0 ? 68 * (23 + NGE) : 64 * 23 + 4 * 13;
    for (int k = 0; ; ++k) { const int u = xcd_unit(k, nu); if (u >= nu) break;
        int i, j;
        const int nr = l == 0 ? 68 : 64, nc = l == 0 ? 23 + NGE : 23;
        if (u < nr * nc) { const int w0 = (nc + 2) / 3, w1 = (nc - w0 + 1) / 2; int v = u, j0 = 0, w = w0;
            if (v >= nr * w0) { v -= nr * w0; j0 = w0; w = w1; if (v >= nr * w1) { v -= nr * w1; j0 = w0 + w1; w = nc - w0 - w1; } }
            const int il = v / w; j = j0 + v % w; i = l == 0 ? il : (il >> 4) * 17 + 1 + (il & 15); }
        else { const int v = u - 64 * 23; i = (v / 13) * 17; const int q = v % 13; j = q < 10 ? 8 + q : (q < 12 ? 20 + (q - 10) : 22); }
        f32x4 acc[2][2][4][2];
        AMapId am{(i * 256 + R0) * 1024 + C0, 1024};
        gemm_tile(H, W, 1024, am, (j * 256 + bperm(R0)) * 1024 + C0, acc, shm); EPI_LANES;
        if (j < 22) {
            size_t base; int wdt, c0;
            if (j < 12) { base = (size_t)(j >> 1) * 2 * U; wdt = 512; c0 = (j & 1) * 256; }
            else if (j == 12) { base = WS_AK; wdt = 256; c0 = 0; }
            else if (j == 13) { base = WS_AV; wdt = 256; c0 = 0; }
            else if (j < 18) { base = WS_XBC; wdt = 1024; c0 = (j - 14) * 256; }
            else if (j < 20) { base = WS_GQ; wdt = 512; c0 = (j - 18) * 256; }
            else { base = WS_GK; wdt = 512; c0 = (j - 20) * 256; }
            bf16_t* O = (bf16_t*)(a->ws + base);
#pragma unroll
            for (int ai = 0; ai < 2; ++ai)
#pragma unroll
                for (int m = 0; m < 4; ++m) { const int row = i * 256 + ai * 128 + wr * 64 + m * 16 + fr;
#pragma unroll
                    for (int bj = 0; bj < 2; ++bj) { const int col = c0 + bj * 128 + wc * 32 + fq * 8; const f32x4 v = acc[ai][bj][m][0], v2 = acc[ai][bj][m][1];
                            u32x4 w = {cvtpk(v[0], v[1]), cvtpk(v[2], v[3]), cvtpk(v2[0], v2[1]), cvtpk(v2[2], v2[3])}; *(u32x4*)(O + (size_t)row * wdt + col) = w; } }
        } else if (j == 22) {
            float* O = (float*)(a->ws + WS_SM);
#pragma unroll
            for (int ai = 0; ai < 2; ++ai)
#pragma unroll
                for (int m = 0; m < 4; ++m) { const int row = i * 256 + ai * 128 + wr * 64 + m * 16 + fr;
#pragma unroll
                    for (int n = 0; n < 2; ++n) { const int col = wc * 32 + fq * 8 + n * 4;
                        if (col < 48) *(f32x4*)(O + (size_t)row * 48 + col) = acc[ai][0][m][n]; } }
        } else {
            bf16_t* O = (bf16_t*)(a->ws + WS_GE); const int c0 = (j - 23) * 256;
#pragma unroll
            for (int ai = 0; ai < 2; ++ai)
#pragma unroll
                for (int m = 0; m < 4; ++m) { const int row = i * 256 + ai * 128 + wr * 64 + m * 16 + fr;
#pragma unroll
                    for (int bj = 0; bj < 2; ++bj) { const int col = c0 + bj * 128 + wc * 32 + fq * 8; const f32x4 v = acc[ai][bj][m][0], v2 = acc[ai][bj][m][1];
                            u32x4 w = {cvtpk(sigmoidf_(v[0]), sigmoidf_(v[1])), cvtpk(sigmoidf_(v[2]), sigmoidf_(v[3])), cvtpk(sigmoidf_(v2[0]), sigmoidf_(v2[1])), cvtpk(sigmoidf_(v2[2]), sigmoidf_(v2[3]))};
                            *(u32x4*)(O + (size_t)row * (NGE * 256) + col) = w; } }
        }
    }
}
__device__ __forceinline__ void ph_gemm_gates(KArgs a, int l, char* shm) {
    const bf16_t* H = (const bf16_t*)(a->ws + WS_H); const bf16_t* W = (const bf16_t*)(a->ws + WS_WIN) + (size_t)5888 * 1024;
    int R0, C0; stage_coords(R0, C0);
    const int j0 = l == 0 ? NGE : 0, nj = 16 - j0;
    const int nrt = n_row_tiles(l); const int nu = nrt * nj; const int G = gridDim.x, bx = blockIdx.x;
    const int ntl = bx < nu ? (nu - bx + G - 1) / G : 0;
    auto coords = [&](int k, int& i, int& j) { int v = xcd_unit(k, nu); const int w0 = (nj + 1) >> 1; int jb = 0, w = w0; if (v >= nrt * w0) { v -= nrt * w0; jb = w0; w = nj - w0; } i = v / w; j = j0 + jb + v % w; };
    gemm_stream<AMapId>(1024, ntl,
        [&](int k, const bf16_t*& A, const bf16_t*& B, AMapId& am, unsigned& bo) { int i, j; coords(k, i, j); A = H; B = W; am = AMapId{(row_tile_base(l, i) + R0) * 1024 + C0, 1024}; bo = (unsigned)((j * 256 + bperm(R0)) * 1024 + C0) * 2u; },
        [&](int k, f32x4 (&acc)[2][2][4][2]) { int i, j; coords(k, i, j); const int rb = row_tile_base(l, i); EPI_LANES;
            bf16_t* O = (bf16_t*)(a->ws + WS_GATES + (size_t)(j >> 2) * 4 * U); const int c0 = (j & 3) * 256;
#pragma unroll
            for (int ai = 0; ai < 2; ++ai)
#pragma unroll
                for (int m = 0; m < 4; ++m) { const int row = rb + ai * 128 + wr * 64 + m * 16 + fr;
#pragma unroll
                    for (int bj = 0; bj < 2; ++bj) { const int col = c0 + bj * 128 + wc * 32 + fq * 8; const f32x4 v = acc[ai][bj][m][0], v2 = acc[ai][bj][m][1];
                            u32x4 w = {cvtpk(sigmoidf_(v[0]), sigmoidf_(v[1])), cvtpk(sigmoidf_(v[2]), sigmoidf_(v[3])), cvtpk(sigmoidf_(v2[0]), sigmoidf_(v2[1])), cvtpk(sigmoidf_(v2[2]), sigmoidf_(v2[3]))};
                            *(u32x4*)(O + (size_t)row * 1024 + col) = w; } } },
        shm);
}

namespace lru {
constexpr int TS = 128, NT = SEQ / TS;
constexpr int OFF_U = 0, OFF_WA = 16384, OFF_WX = 24576, OFF_AT = 32768, OFF_VT = 65536, OFF_HF = 98304, OFF_COMP = LDS_MAIN + 256, OFF_H0 = OFF_COMP + 4096;
__device__ __forceinline__ int uswz(int row, int cb) { return row * 128 + (cb ^ ((row & 7) << 4)); }
__device__ __forceinline__ int crow(int r, int hi) { return (r & 3) + 8 * (r >> 2) + 4 * hi; }
__device__ __forceinline__ float* sum_ptr(KArgs a, int b, int dir, int t) { return (float*)(a->ws + WS_LSUM) + ((size_t)((b * 2 + dir) * NT + t)) * 1024; }
__device__ __forceinline__ void conv_u(KArgs a, int l, int b, int t, int n, char* shm, int tid) {
    const bf16_t* LX = (const bf16_t*)(a->ws + WS_LX); const int pb = t * TS; const int slo = t < 2 ? 0 : CTX, shi = t < 2 ? CTX : SEQ;
    const int sg = tid & 7, ch0 = n * 64 + sg * 8;
    float cw[4][8], cb[8];
#pragma unroll
    for (int k = 0; k < 4; ++k) { const f32x4 w0 = *(const f32x4*)(a->in[18] + (l * 4 + k) * 512 + ch0), w1 = *(const f32x4*)(a->in[18] + (l * 4 + k) * 512 + ch0 + 4);
#pragma unroll
        for (int j = 0; j < 4; ++j) { cw[k][j] = w0[j]; cw[k][4 + j] = w1[j]; } }
    { const f32x4 b0 = *(const f32x4*)(a->in[19] + l * 512 + ch0), b1 = *(const f32x4*)(a->in[19] + l * 512 + ch0 + 4);
#pragma unroll
      for (int j = 0; j < 4; ++j) { cb[j] = b0[j]; cb[4 + j] = b1[j]; } }
#pragma unroll
    for (int q = 0; q < 2; ++q) { const int pos = (tid >> 3) + q * 64; float u[8];
#pragma unroll
        for (int j = 0; j < 8; ++j) u[j] = cb[j];
#pragma unroll
        for (int k = 0; k < 4; ++k) { const int p = pb + pos + k - 2;
            if (p >= slo && p < shi) { const u32x4 xv = *(const u32x4*)(LX + (size_t)(b * SEQ + p) * 512 + ch0);
#pragma unroll
                for (int j = 0; j < 4; ++j) { u[2 * j] += cw[k][2 * j] * lo_bf(xv[j]); u[2 * j + 1] += cw[k][2 * j + 1] * hi_bf(xv[j]); } } }
        u32x4 o = {cvtpk(u[0], u[1]), cvtpk(u[2], u[3]), cvtpk(u[4], u[5]), cvtpk(u[6], u[7])};
        *(u32x4*)(shm + OFF_U + uswz(pos, sg * 16)) = o; }
}
__device__ __forceinline__ bf16_t* la_ptr(KArgs a, int dir) { return (bf16_t*)(a->ws + (dir ? WS_E13 : WS_TMP + 4 * U)); }
__device__ __forceinline__ bf16_t* lv_ptr(KArgs a, int dir) { return (bf16_t*)(a->ws + (dir ? WS_E13 : WS_TMP + 4 * U) + 2 * U); }
__device__ __forceinline__ void composites(int dir, char* shm, int tid) {
    const float* at = (const float*)(shm + OFF_AT); const float* vt = (const float*)(shm + OFF_VT);
    const int cc = tid & 63, sgm = tid >> 6; float A = 1.f, H = 0.f;
#pragma unroll
    for (int i = 0; i < 16; ++i) { const int w = sgm * 16 + i; const int pos = dir ? 127 - w : w; const float av = at[pos * 64 + cc]; H = av * H + vt[pos * 64 + cc]; A *= av; }
    float* comp = (float*)(shm + OFF_COMP); comp[(sgm * 64 + cc) * 2] = A; comp[(sgm * 64 + cc) * 2 + 1] = H;
    __syncthreads();
}
__device__ __forceinline__ void gates_dir(KArgs a, int l, int n, int dir, char* shm, int tid) {
    const int wid = tid >> 6, lane = tid & 63, r32 = lane & 31, hi = lane >> 5;
    {
        const int c = tid & 63, kg = tid >> 6; const float* pa = a->in[20] + ((size_t)((l * 2 + dir) * 8 + n)) * 4096 + c; const float* px = a->in[22] + ((size_t)((l * 2 + dir) * 8 + n)) * 4096 + c;
        float va[8], vx[8];
#pragma unroll
        for (int j = 0; j < 8; ++j) { va[j] = pa[(kg * 8 + j) * 64]; vx[j] = px[(kg * 8 + j) * 64]; }
        u32x4 oa = {cvtpk(va[0], va[1]), cvtpk(va[2], va[3]), cvtpk(va[4], va[5]), cvtpk(va[6], va[7])}, ox = {cvtpk(vx[0], vx[1]), cvtpk(vx[2], vx[3]), cvtpk(vx[4], vx[5]), cvtpk(vx[6], vx[7])};
        *(u32x4*)(shm + OFF_WA + uswz(c, kg * 16)) = oa; *(u32x4*)(shm + OFF_WX + uswz(c, kg * 16)) = ox; }
    __syncthreads();
    const int rb = wid >> 1, cbk = wid & 1;
    f32x16 accA = {}, accX = {};
#pragma unroll
    for (int ks = 0; ks < 4; ++ks) { const int cb = (ks * 16 + hi * 8) * 2;
        const bf16x8 fu = *(const bf16x8*)(shm + OFF_U + uswz(rb * 32 + r32, cb)), fa = *(const bf16x8*)(shm + OFF_WA + uswz(cbk * 32 + r32, cb)), fx = *(const bf16x8*)(shm + OFF_WX + uswz(cbk * 32 + r32, cb));
        accA = __builtin_amdgcn_mfma_f32_32x32x16_bf16(fu, fa, accA, 0, 0, 0); accX = __builtin_amdgcn_mfma_f32_32x32x16_bf16(fu, fx, accX, 0, 0, 0); }
    const int c = cbk * 32 + r32, ch = n * 64 + c;
    const float ba = a->in[21][(l * 2 + dir) * 512 + ch], bx = a->in[23][(l * 2 + dir) * 512 + ch];
    const float lam8 = -8.f * softplus_rel(-a->in[24][(l * 2 + dir) * 512 + ch]);
    float* at = (float*)(shm + OFF_AT); float* vt = (float*)(shm + OFF_VT); float* lt = (float*)(shm + OFF_HF);
#pragma unroll
    for (int r = 0; r < 16; ++r) { const int pos = rb * 32 + crow(r, hi);
        const float rg = sigmoidf_(accA[r] + ba), ig = sigmoidf_(accX[r] + bx); const float la = bf2f(f2bf(lam8 * rg)); const float x2 = 2.f * la;
        const float om = x2 > -0.02f ? -x2 * (1.f + x2 * (0.5f + x2 * (0.16666667f + x2 * 0.041666668f))) : 1.f - __expf(x2);
        const float uu = bf2f(*(const bf16_t*)(shm + OFF_U + uswz(pos, c * 2)));
        at[pos * 64 + c] = __expf(la); vt[pos * 64 + c] = bf2f(f2bf(uu * ig * __builtin_amdgcn_sqrtf(om))); lt[pos * 64 + c] = la; }
    __syncthreads();
}
__device__ __forceinline__ void pass_a(KArgs a, int l, char* shm) {
    for (int u = blockIdx.x; u < NB * NT * 8; u += gridDim.x) { const int b = u / (NT * 8), rem = u % (NT * 8); const int t = rem >> 3, n = rem & 7;
        const int tid = ltid();
        conv_u(a, l, b, t, n, shm, tid);
        for (int dir = 0; dir < 2; ++dir) {
            gates_dir(a, l, n, dir, shm, tid);
            {
                const int pos = tid >> 2, c0 = (tid & 3) * 16; const float* lp = (const float*)(shm + OFF_HF) + pos * 64 + c0; const float* vp = (const float*)(shm + OFF_VT) + pos * 64 + c0;
                const size_t o = ((size_t)b * SEQ + t * TS + pos) * 512 + n * 64 + c0;
                u32x4 w0 = {cvtpk(lp[0], lp[1]), cvtpk(lp[2], lp[3]), cvtpk(lp[4], lp[5]), cvtpk(lp[6], lp[7])}, w1 = {cvtpk(lp[8], lp[9]), cvtpk(lp[10], lp[11]), cvtpk(lp[12], lp[13]), cvtpk(lp[14], lp[15])};
                *(u32x4*)(la_ptr(a, dir) + o) = w0; *(u32x4*)(la_ptr(a, dir) + o + 8) = w1;
                u32x4 x0 = {cvtpk(vp[0], vp[1]), cvtpk(vp[2], vp[3]), cvtpk(vp[4], vp[5]), cvtpk(vp[6], vp[7])}, x1 = {cvtpk(vp[8], vp[9]), cvtpk(vp[10], vp[11]), cvtpk(vp[12], vp[13]), cvtpk(vp[14], vp[15])};
                *(u32x4*)(lv_ptr(a, dir) + o) = x0; *(u32x4*)(lv_ptr(a, dir) + o + 8) = x1; }
            composites(dir, shm, tid);
            if (tid < 64) { const float* comp = (const float*)(shm + OFF_COMP); float A = 1.f, H = 0.f;
#pragma unroll
                for (int sg = 0; sg < 8; ++sg) { const float ca = comp[(sg * 64 + tid) * 2], chh = comp[(sg * 64 + tid) * 2 + 1]; H = ca * H + chh; A *= ca; }
                float* sp = sum_ptr(a, b, dir, t) + (n * 64 + tid) * 2; sp[0] = A; sp[1] = H; }
            __syncthreads();
        }
    }
}
__device__ __forceinline__ void pass_b(KArgs a, int l, char* shm) {
    bf16_t* LG = (bf16_t*)(a->ws + WS_LG);
    const int nub = l == 1 ? NB * (NT - 2) * 8 : NB * NT * 8;
    for (int u = blockIdx.x; u < nub; u += gridDim.x) { int b, rem; if (l == 1) { b = u / ((NT - 2) * 8); rem = u % ((NT - 2) * 8) + 16; } else { b = u / (NT * 8); rem = u % (NT * 8); } const int t = rem >> 3, n = rem & 7;
        const int tid = ltid();
        const int lpos = tid >> 2, lc0 = (tid & 3) * 16; const size_t lo = ((size_t)b * SEQ + t * TS + lpos) * 512 + n * 64 + lc0;
        bf16_t lgv[16];
        {   const int cc_ = tid & 63, sgm_ = tid >> 6;
#pragma unroll
            for (int i = 0; i < 16; ++i) { const int pos = 127 - (sgm_ * 16 + i); lgv[i] = LG[((size_t)b * SEQ + t * TS + pos) * 512 + n * 64 + cc_]; } }
        u32x4 rl[2][2], rv[2][2];
#pragma unroll
        for (int dir = 0; dir < 2; ++dir) { rl[dir][0] = *(const u32x4*)(la_ptr(a, dir) + lo); rl[dir][1] = *(const u32x4*)(la_ptr(a, dir) + lo + 8); rv[dir][0] = *(const u32x4*)(lv_ptr(a, dir) + lo); rv[dir][1] = *(const u32x4*)(lv_ptr(a, dir) + lo + 8); }
        {   float* stg = (float*)(shm + OFF_AT);
            f32x4 sv[5];
#pragma unroll
            for (int q = 0; q < 5; ++q) { const int i = tid + q * NTHREADS; const int ii = i < 2 * NT * 32 ? i : 0; const int dir = ii / (NT * 32), r = ii % (NT * 32); const int tt = r >> 5, c4 = r & 31;
                sv[q] = *(const f32x4*)(sum_ptr(a, b, dir, tt) + n * 128 + c4 * 4); }
#pragma unroll
            for (int q = 0; q < 5; ++q) { const int i = tid + q * NTHREADS; if (i < 2 * NT * 32) *(f32x4*)(stg + i * 4) = sv[q]; }
            __syncthreads();
            {   const int dir = (tid >> 6) & 1, c = tid & 63, sgq = tid >> 7; float A = 1.f, H = 0.f;
                int kt = 0; for (int k = 0; k < NT; ++k) { const int tt = dir == 0 ? k : (k < 2 ? 1 - k : NT + 1 - k); if (tt == t) { kt = k; break; } }
#pragma unroll
                for (int q = 0; q < 9; ++q) { const int k = sgq * 9 + q; if (k < kt && k < NT) { const int tt = dir == 0 ? k : (k < 2 ? 1 - k : NT + 1 - k);
                        const float* e = stg + ((dir * NT + tt) * 64 + c) * 2; H = e[0] * H + e[1]; A *= e[0]; } }
                float* cst = (float*)(shm + OFF_HF);
                cst[((sgq * 2 + dir) * 64 + c) * 2] = A; cst[((sgq * 2 + dir) * 64 + c) * 2 + 1] = H; }
            __syncthreads();
            if (tid < 128) { const int dir = tid >> 6, c = tid & 63; const float* cst = (const float*)(shm + OFF_HF); float h = 0.f;
#pragma unroll
                for (int q = 0; q < 4; ++q) { const float* e = cst + ((q * 2 + dir) * 64 + c) * 2; h = e[0] * h + e[1]; }
                ((float*)(shm + OFF_H0))[tid] = h; }
            __syncthreads();
        }
        for (int dir = 0; dir < 2; ++dir) {
            {   float* atw = (float*)(shm + OFF_AT) + lpos * 64 + lc0; float* vtw = (float*)(shm + OFF_VT) + lpos * 64 + lc0;
#pragma unroll
                for (int h2 = 0; h2 < 2; ++h2)
#pragma unroll
                    for (int e = 0; e < 4; ++e) { atw[h2 * 8 + 2 * e] = __expf(lo_bf(rl[dir][h2][e])); atw[h2 * 8 + 2 * e + 1] = __expf(hi_bf(rl[dir][h2][e])); vtw[h2 * 8 + 2 * e] = lo_bf(rv[dir][h2][e]); vtw[h2 * 8 + 2 * e + 1] = hi_bf(rv[dir][h2][e]); } }
            __syncthreads();
            composites(dir, shm, tid);
            const float* at = (const float*)(shm + OFF_AT); const float* vt = (const float*)(shm + OFF_VT); const float* comp = (const float*)(shm + OFF_COMP); float* hf = (float*)(shm + OFF_HF);
            const int cc = tid & 63, sgm = tid >> 6; float H = ((const float*)(shm + OFF_H0))[dir * 64 + cc];
            for (int sg = 0; sg < sgm; ++sg) H = comp[(sg * 64 + cc) * 2] * H + comp[(sg * 64 + cc) * 2 + 1];
#pragma unroll
            for (int i = 0; i < 16; ++i) { const int w = sgm * 16 + i; const int pos = dir ? 127 - w : w; H = at[pos * 64 + cc] * H + vt[pos * 64 + cc];
                if (dir == 0) hf[pos * 64 + cc] = H;
                else { const size_t row = (size_t)b * SEQ + t * TS + pos; LG[row * 512 + n * 64 + cc] = f2bf((hf[pos * 64 + cc] + H) * gelu_tanh(bf2f(lgv[i]))); } }
            __syncthreads();
        }
    }
}
}

__device__ __forceinline__ void ph_prep(KArgs a, int l, char* shm) {
    float* cw = (float*)shm;
    float* g2 = cw + 5 * 1024;
    float* gb = g2 + 2 * 16 * 512;
    const int tid = ltid(), lane = tid & 63, wv = tid >> 6;
    for (int i = tid; i < 4 * 1024; i += NTHREADS) cw[i] = a->in[9][l * 4096 + i];
    for (int i = tid; i < 1024; i += NTHREADS) cw[4096 + i] = a->in[10][l * 1024 + i];
    for (int i = tid; i < 2 * 16 * 512; i += NTHREADS) g2[i] = a->in[15][l * 2 * 16 * 512 + i];
    for (int i = tid; i < 1024; i += NTHREADS) gb[i] = a->in[16][l * 1024 + i];
    float* rtab = gb + 1024;
    for (int i = tid; i < 2048; i += NTHREADS) { const int p = i >> 5, f = i & 31; float sn, cs; sincosf((float)p * __builtin_amdgcn_exp2f(-(float)f * 0.41524101186092029f), &sn, &cs);     rtab[2 * i] = cs; rtab[2 * i + 1] = sn; }
    __syncthreads();
    const bf16_t* HF = (const bf16_t*)(a->ws + WS_HF); const bf16_t* HB = (const bf16_t*)(a->ws + WS_HB); bf16_t* LG = (bf16_t*)(a->ws + WS_LG);
    const bf16_t* XBC = (const bf16_t*)(a->ws + WS_XBC); bf16_t* XC = (bf16_t*)(a->ws + WS_XBCC);
    const float* SM = (const float*)(a->ws + WS_SM); float* DTV = (float*)(a->ws + WS_DTV); bf16_t* G = (bf16_t*)(a->ws + WS_G);
    bf16_t* AQ = (bf16_t*)(a->ws + WS_AQ); bf16_t* AK = (bf16_t*)(a->ws + WS_AK);
    const float* qn = a->in[25] + l * 128; const float* kn = a->in[26] + l * 128;
    const float qn1 = qn[(lane >> 5) * 64 + (lane & 31)], qn2 = qn[(lane >> 5) * 64 + (lane & 31) + 32], kn1 = kn[(lane >> 5) * 64 + (lane & 31)], kn2 = kn[(lane >> 5) * 64 + (lane & 31) + 32];
    const float dtb = a->in[11][l * 16 + (lane & 15)];
    for (int row = blockIdx.x * 8 + wv; row < T; row += gridDim.x * 8) {
        const int b = row / SEQ, pos = row - b * SEQ; const bool isctx = pos < CTX;
        __builtin_amdgcn_sched_barrier(0);
        const float smv = SM[(size_t)row * 48 + (lane & 15)];
        float x1v[6], x2v[6];
#pragma unroll
        for (int hd = 0; hd < 6; ++hd) { const bf16_t* base = hd < 4 ? AQ + (size_t)row * 512 + hd * 128 : AK + (size_t)row * 256 + (hd - 4) * 128; x1v[hd] = bf2f(base[(lane >> 5) * 64 + (lane & 31)]); x2v[hd] = bf2f(base[(lane >> 5) * 64 + (lane & 31) + 32]); }
        {   const int slo = isctx ? 0 : CTX, shi = isctx ? CTX : SEQ;
            u32x4 xt[2][4];
#pragma unroll
            for (int hh = 0; hh < 2; ++hh)
#pragma unroll
                for (int k = 0; k < 4; ++k) { const int p = pos + k - 2; const bool ok = p >= slo && p < shi; const u32x4 xv = *(const u32x4*)(XBC + (size_t)(b * SEQ + (ok ? p : pos)) * 1024 + hh * 512 + lane * 8);
                    xt[hh][k] = ok ? xv : (u32x4){0u, 0u, 0u, 0u}; }
#pragma unroll
            for (int hh = 0; hh < 2; ++hh) { const int c0 = hh * 512 + lane * 8; float accv[8];
#pragma unroll
                for (int j = 0; j < 8; ++j) accv[j] = cw[4096 + c0 + j];
#pragma unroll
                for (int k = 0; k < 4; ++k) { const u32x4 xv = xt[hh][k];
#pragma unroll
                        for (int j = 0; j < 4; ++j) { accv[2 * j] += cw[k * 1024 + c0 + 2 * j] * lo_bf(xv[j]); accv[2 * j + 1] += cw[k * 1024 + c0 + 2 * j + 1] * hi_bf(xv[j]); } }
                u32x4 o;
#pragma unroll
                for (int j = 0; j < 4; ++j) o[j] = cvtpk(siluf_(accv[2 * j]), siluf_(accv[2 * j + 1]));
                *(u32x4*)(XC + (size_t)row * 1024 + c0) = o; } }
        __builtin_amdgcn_sched_barrier(0);
        if (lane < 16) DTV[(size_t)row * 16 + lane] = softplus_fast(smv + dtb);
        __builtin_amdgcn_sched_barrier(0);
        {   const int hf = lane >> 5, i = lane & 31; const int t = pos - CTX; const int pp = isctx ? 0 : (hf ? (t & 63) : (t >> 6));
            float cs = rtab[(pp * 32 + i) * 2], sn = rtab[(pp * 32 + i) * 2 + 1];
            if (isctx) { sn = 0.f; cs = 1.f; }
#pragma unroll
            for (int hd = 0; hd < 6; ++hd) { bf16_t* base = hd < 4 ? AQ + (size_t)row * 512 + hd * 128 : AK + (size_t)row * 256 + (hd - 4) * 128;
                const int d1 = hf * 64 + i, d2 = d1 + 32; float x1 = x1v[hd], x2 = x2v[hd];
                const float ss = wave_sum(x1 * x1 + x2 * x2); const float r = rsqrtf(ss * (1.f / 128.f) + EPS);
                x1 = x1 * r * (hd < 4 ? qn1 : kn1); x2 = x2 * r * (hd < 4 ? qn2 : kn2);
                base[d1] = f2bf(x1 * cs - x2 * sn); base[d2] = f2bf(x1 * sn + x2 * cs); } }
    }
}

namespace att {
constexpr int DH = 128, NW = 8, QBLK = 32, KVBLK = 64;
constexpr float SCALE = 0.088388347648318440f, THR = 8.f;
constexpr int LDQ = 512, LDK = 256, LDO = 512;
constexpr size_t SHM_V = KVBLK * DH * 2, SHM_K = KVBLK * DH * 2, SHM_ATTN = 2 * SHM_V + 2 * SHM_K + NW * 64 * 4;
#define KSWZ(row, colB) ((row) * 256 + ((colB) ^ (((row) & 7) << 4)))
#define SBAR() __builtin_amdgcn_sched_barrier(0)
__device__ __forceinline__ int crow(int r, int hi) { return (r & 3) + 8 * (r >> 2) + 4 * hi; }
__device__ __forceinline__ void partialSM(f32x16& p0, f32x16& p1, float& m_reg, float& mn, float& alpha) {
  constexpr float C = SCALE * 1.4426950408889634f;
  float pmax = p0[0]; for (int r = 1; r < 16; ++r) pmax = fmaxf(pmax, p0[r]); for (int r = 0; r < 16; ++r) pmax = fmaxf(pmax, p1[r]);
  { auto rr = __builtin_amdgcn_permlane32_swap(__float_as_uint(pmax), __float_as_uint(pmax), false, false);
    pmax = fmaxf(__uint_as_float(rr[0]), __uint_as_float(rr[1])); }
  if (__builtin_expect(__all(pmax - m_reg <= THR / SCALE), 1)) { mn = m_reg; alpha = 1.f; }
  else { mn = fmaxf(m_reg, pmax); alpha = __builtin_amdgcn_exp2f((m_reg - mn) * C); m_reg = mn; }
  float mnC = -mn * C;
  for (int r = 0; r < 16; ++r) p0[r] = fmaf(p0[r], C, mnC); for (int r = 0; r < 16; ++r) p1[r] = fmaf(p1[r], C, mnC);
  for (int r = 0; r < 16; ++r) p0[r] = __builtin_amdgcn_exp2f(p0[r]);
}
__device__ __forceinline__ void finishSM(f32x16& p0, f32x16& p1, float alpha, float& l_reg, bf16x8& pa0, bf16x8& pa1, bf16x8& pa2, bf16x8& pa3) {
  for (int r = 0; r < 16; ++r) p1[r] = __builtin_amdgcn_exp2f(p1[r]);
  float ps = 0; for (int r = 0; r < 16; ++r) ps += p0[r]; for (int r = 0; r < 16; ++r) ps += p1[r];
  { auto rr = __builtin_amdgcn_permlane32_swap(__float_as_uint(ps), __float_as_uint(ps), false, false);
    ps = __uint_as_float(rr[0]) + __uint_as_float(rr[1]); }
  l_reg = l_reg * alpha + ps;
#define PK4(P, BASE, OUT) do { unsigned a0 = cvtpk_asm(P[BASE + 0], P[BASE + 1]), a1 = cvtpk_asm(P[BASE + 2], P[BASE + 3]);   \
    unsigned b0 = cvtpk_asm(P[BASE + 4], P[BASE + 5]), b1 = cvtpk_asm(P[BASE + 6], P[BASE + 7]);                              \
    auto r0 = __builtin_amdgcn_permlane32_swap(a0, b0, false, false); auto r1 = __builtin_amdgcn_permlane32_swap(a1, b1, false, false); \
    u32x4 w = {r0[0], r1[0], r0[1], r1[1]}; OUT = *reinterpret_cast<bf16x8*>(&w); } while (0)
  PK4(p0, 0, pa0); PK4(p0, 8, pa1); PK4(p1, 0, pa2); PK4(p1, 8, pa3);
#undef PK4
}
__device__ __forceinline__ void qkt(f32x16& p0, f32x16& p1, const bf16_t* Ks, const bf16x8* qr, int r32, int hi) {
  p0 = f32x16{}; p1 = f32x16{};
  for (int d0 = 0; d0 < 8; ++d0) { int cb = (d0 * 16 + hi * 8) * 2;
    bf16x8 b0 = *reinterpret_cast<const bf16x8*>((const char*)Ks + KSWZ(r32, cb));
    bf16x8 b1 = *reinterpret_cast<const bf16x8*>((const char*)Ks + KSWZ(32 + r32, cb));
    p0 = __builtin_amdgcn_mfma_f32_32x32x16_bf16(b0, qr[d0], p0, 0, 0, 0);
    p1 = __builtin_amdgcn_mfma_f32_32x32x16_bf16(b1, qr[d0], p1, 0, 0, 0); }
}
__device__ __forceinline__ int v_st(int k, int c) { const int kk = (k & ~0xC) | ((k & 4) << 1) | ((k & 8) >> 1); return ((kk >> 3) * 4 + (c >> 5)) * 512 + ((kk & 7) * 32 + (c & 31)) * 2; }
__device__ __forceinline__ int v_rd_base(int lane) { return ((lane & 3) << 3) | (((lane >> 2) & 3) << 6) | (((lane >> 4) & 1) << 5) | (((lane >> 5) & 1) << 8); }
constexpr int v_rd_off(int d0, int ks, int half) { return d0 * 512 + ks * 4096 + half * 2048; }
template <int OFF> __device__ __forceinline__ s16x4 tr_read(int vb) {
  s16x4 r; asm volatile("ds_read_b64_tr_b16 %0, %1 offset:%2" : "=&v"(r) : "v"(vb), "i"(OFF) : "memory"); return r;
}
template <int D0> __device__ __forceinline__ void pv_one(f32x16& od, int vb, bf16x8 pa0, bf16x8 pa1, bf16x8 pa2, bf16x8 pa3) {
  const s16x4 l0 = tr_read<v_rd_off(D0, 0, 0)>(vb), h0 = tr_read<v_rd_off(D0, 0, 1)>(vb), l1 = tr_read<v_rd_off(D0, 1, 0)>(vb), h1 = tr_read<v_rd_off(D0, 1, 1)>(vb);
  const s16x4 l2 = tr_read<v_rd_off(D0, 2, 0)>(vb), h2 = tr_read<v_rd_off(D0, 2, 1)>(vb), l3 = tr_read<v_rd_off(D0, 3, 0)>(vb), h3 = tr_read<v_rd_off(D0, 3, 1)>(vb);
  asm volatile("s_waitcnt lgkmcnt(0)" ::: "memory"); SBAR();
#define PK(L, H) (bf16x8){L[0], L[1], L[2], L[3], H[0], H[1], H[2], H[3]}
  od = __builtin_amdgcn_mfma_f32_32x32x16_bf16(pa0, PK(l0, h0), od, 0, 0, 0);
  od = __builtin_amdgcn_mfma_f32_32x32x16_bf16(pa1, PK(l1, h1), od, 0, 0, 0);
  od = __builtin_amdgcn_mfma_f32_32x32x16_bf16(pa2, PK(l2, h2), od, 0, 0, 0);
  od = __builtin_amdgcn_mfma_f32_32x32x16_bf16(pa3, PK(l3, h3), od, 0, 0, 0);
#undef PK
}
template <int D0> __device__ __forceinline__ void pv_oneT(f32x16& od, int vb, bf16x8 pa0, bf16x8 pa1, bf16x8 pa2, bf16x8 pa3) {
  const s16x4 l0 = tr_read<v_rd_off(D0, 0, 0)>(vb), h0 = tr_read<v_rd_off(D0, 0, 1)>(vb), l1 = tr_read<v_rd_off(D0, 1, 0)>(vb), h1 = tr_read<v_rd_off(D0, 1, 1)>(vb);
  const s16x4 l2 = tr_read<v_rd_off(D0, 2, 0)>(vb), h2 = tr_read<v_rd_off(D0, 2, 1)>(vb), l3 = tr_read<v_rd_off(D0, 3, 0)>(vb), h3 = tr_read<v_rd_off(D0, 3, 1)>(vb);
  asm volatile("s_waitcnt lgkmcnt(0)" ::: "memory"); SBAR();
#define PK(L, H) (bf16x8){L[0], L[1], L[2], L[3], H[0], H[1], H[2], H[3]}
  od = __builtin_amdgcn_mfma_f32_32x32x16_bf16(PK(l0, h0), pa0, od, 0, 0, 0);
  od = __builtin_amdgcn_mfma_f32_32x32x16_bf16(PK(l1, h1), pa1, od, 0, 0, 0);
  od = __builtin_amdgcn_mfma_f32_32x32x16_bf16(PK(l2, h2), pa2, od, 0, 0, 0);
  od = __builtin_amdgcn_mfma_f32_32x32x16_bf16(PK(l3, h3), pa3, od, 0, 0, 0);
#undef PK
}
__device__ __forceinline__ void pv_d0(f32x16* o, int vb, bf16x8 pa0, bf16x8 pa1, bf16x8 pa2, bf16x8 pa3) {
  pv_oneT<0>(o[0], vb, pa0, pa1, pa2, pa3); pv_oneT<1>(o[1], vb, pa0, pa1, pa2, pa3); pv_oneT<2>(o[2], vb, pa0, pa1, pa2, pa3); pv_oneT<3>(o[3], vb, pa0, pa1, pa2, pa3);
}
__device__ __forceinline__ void attn_dense_body(const bf16_t* __restrict__ Qb, const bf16_t* __restrict__ Kh, const bf16_t* __restrict__ Vh,
                                                bf16_t* __restrict__ Ob, int seq, char* lds) {
  const int tid = ltid(), wid = tid >> 6, lane = tid & 63, r32 = lane & 31, hi = lane >> 5;
  bf16_t* V_lds = (bf16_t*)lds; bf16_t* K_lds = (bf16_t*)(lds + 2 * SHM_V);
  float* ws = (float*)(lds + 2 * SHM_V + 2 * SHM_K) + wid * 64; float* li_l = ws; float* al_l = ws + 32;
  float m_reg = -1e30f, l_reg = 0; f32x16 o[4] = {}; bf16x8 qr[8];
  const bf16_t* Qw = Qb + (long)(wid * QBLK + r32) * LDQ + hi * 8;
#pragma unroll
  for (int d0 = 0; d0 < 8; ++d0) qr[d0] = *reinterpret_cast<const bf16x8*>(Qw + d0 * 16);
  const int sr = tid >> 4, sc = (tid & 15) * 8, vst0 = v_st(sr, sc), vst1 = v_st(32 + sr, sc);
  const int vb0 = (int)(uintptr_t)V_lds + v_rd_base(lane);
  struct { bf16x8 vs0, vs1, ks0, ks1; } sr_[2];
#define SLOAD(i, k0) do { sr_[i].vs0 = *(const bf16x8*)(&Vh[(long)((k0) + sr) * LDK + sc]); sr_[i].vs1 = *(const bf16x8*)(&Vh[(long)((k0) + 32 + sr) * LDK + sc]); \
    sr_[i].ks0 = *(const bf16x8*)(&Kh[(long)((k0) + sr) * LDK + sc]); sr_[i].ks1 = *(const bf16x8*)(&Kh[(long)((k0) + 32 + sr) * LDK + sc]); } while (0)
#define SWRITE(b, i) do { *(bf16x8*)((char*)V_lds + (b) * SHM_V + vst0) = sr_[i].vs0;          \
    *(bf16x8*)((char*)V_lds + (b) * SHM_V + vst1) = sr_[i].vs1; int kc = sc * 2;               \
    *(bf16x8*)((char*)K_lds + (b) * SHM_K + KSWZ(sr, kc)) = sr_[i].ks0;                       \
    *(bf16x8*)((char*)K_lds + (b) * SHM_K + KSWZ(32 + sr, kc)) = sr_[i].ks1; } while (0)
#define SWAIT() asm volatile("s_waitcnt vmcnt(4)" ::: "memory")
#define RESC(a) do { if (__any((a) < 1.f)) { for (int d = 0; d < 4; ++d) for (int r = 0; r < 16; ++r) o[d][r] *= (a); } } while (0)
  f32x16 pA0, pA1, pB0, pB1; float mnA, mnB, alA, alB; bf16x8 pa0, pa1, pa2, pa3; const int NT = seq / KVBLK;
  constexpr int SE = 0, SO = 1;
  SLOAD(SE, 0); asm volatile("s_waitcnt vmcnt(0)" ::: "memory"); SWRITE(0, SE); __syncthreads();
  qkt(pA0, pA1, K_lds, qr, r32, hi); partialSM(pA0, pA1, m_reg, mnA, alA);
  SLOAD(SO, KVBLK); if (2 < NT) SLOAD(SE, 2 * KVBLK);
  SWAIT(); SWRITE(1, SO); __syncthreads();
  for (int j = 1; j + 1 < NT; j += 2) {
    SBAR(); qkt(pB0, pB1, (bf16_t*)((char*)K_lds + SHM_K), qr, r32, hi);
    finishSM(pA0, pA1, alA, l_reg, pa0, pa1, pa2, pa3); SBAR();
    SLOAD(SO, (j + 2) * KVBLK); SBAR();
    pv_d0(o, vb0, pa0, pa1, pa2, pa3); partialSM(pB0, pB1, m_reg, mnB, alB);
    __syncthreads(); SWAIT(); SWRITE(0, SE);
    RESC(alB); __syncthreads();
    SBAR(); qkt(pA0, pA1, K_lds, qr, r32, hi);
    finishSM(pB0, pB1, alB, l_reg, pa0, pa1, pa2, pa3); SBAR();
    if (j + 3 < NT) SLOAD(SE, (j + 3) * KVBLK); SBAR();
    pv_d0(o, vb0 + (int)SHM_V, pa0, pa1, pa2, pa3); partialSM(pA0, pA1, m_reg, mnA, alA);
    __syncthreads(); SWAIT(); SWRITE(1, SO);
    RESC(alA); __syncthreads();
  }
  SBAR(); qkt(pB0, pB1, (bf16_t*)((char*)K_lds + SHM_K), qr, r32, hi);
  finishSM(pA0, pA1, alA, l_reg, pa0, pa1, pa2, pa3); SBAR();
  pv_d0(o, vb0, pa0, pa1, pa2, pa3); partialSM(pB0, pB1, m_reg, mnB, alB);
  __syncthreads(); RESC(alB);
  finishSM(pB0, pB1, alB, l_reg, pa0, pa1, pa2, pa3); SBAR();
  pv_d0(o, vb0 + (int)SHM_V, pa0, pa1, pa2, pa3);
  {   const float rl = __builtin_amdgcn_rcpf(l_reg);
      bf16_t* Ow = Ob + (long)(wid * QBLK + r32) * LDO + 4 * hi;
#pragma unroll
      for (int d0 = 0; d0 < 4; ++d0)
#pragma unroll
          for (int q = 0; q < 4; ++q) { u32x2 w = {cvtpk(o[d0][4 * q] * rl, o[d0][4 * q + 1] * rl), cvtpk(o[d0][4 * q + 2] * rl, o[d0][4 * q + 3] * rl)}; *(u32x2*)(Ow + d0 * 32 + 8 * q) = w; } }
  __syncthreads();
#undef SLOAD
#undef SWRITE
#undef SWAIT
#undef RESC
}
}


namespace ssd {
constexpr int NCH = SEQ / 128;
constexpr int OFF_CUM = LDS_MAIN + 256, OFF_DT = OFF_CUM + 4096, OFF_TOT = OFF_DT + 4096, OFF_SSQ = OFF_TOT + 64;
__device__ __forceinline__ size_t st_index(int b, int dir, int c, int head) { return ((size_t)((b * 2 + dir) * NCH + c) * 8 + head) * 8192; }
__device__ __forceinline__ void chunk_cums(KArgs a, int l, int b, int c, int g, char* shm, int tid) {
    float* cum = (float*)(shm + OFF_CUM); float* dts = (float*)(shm + OFF_DT); float* tot = (float*)(shm + OFF_TOT);
    const int w = tid >> 6, lane = tid & 63, h4 = w >> 1, dir = w & 1, head = g * 4 + h4;
    const float* DTV = (const float*)(a->ws + WS_DTV); const size_t r0 = (size_t)b * SEQ + c * 128;
    const float ah = -__expf(a->in[12][(l * 2 + dir) * 8 + head]);
    const float d0 = DTV[(r0 + 2 * lane) * 16 + dir * 8 + head], d1 = DTV[(r0 + 2 * lane + 1) * 16 + dir * 8 + head];
    const float v0 = d0 * ah, v1 = d1 * ah; float x = v0 + v1;
#pragma unroll
    for (int o = 1; o < 64; o <<= 1) { const float t = __shfl_up(x, o, 64); if (lane >= o) x += t; }
    const float tt = __shfl(x, 63, 64);
    float c0, c1;
    if (dir == 0) { c0 = x - v1; c1 = x; } else { c0 = tt - (x - v1) + v0; c1 = tt - x + v1; }
    cum[w * 128 + 2 * lane] = c0; cum[w * 128 + 2 * lane + 1] = c1; dts[w * 128 + 2 * lane] = d0; dts[w * 128 + 2 * lane + 1] = d1;
    if (lane == 0) tot[w] = tt;
}
__device__ __forceinline__ void s1_unit(KArgs a, int l, int b, int c, int g, char* shm) {
    const int tid = ltid(), wid = tid >> 6, lane = tid & 63, r32 = lane & 31, hi = lane >> 5;
    const bf16_t* XC = (const bf16_t*)(a->ws + WS_XBCC); const size_t r0 = (size_t)b * SEQ + c * 128;
    float* cum = (float*)(shm + OFF_CUM); float* dts = (float*)(shm + OFF_DT); float* tot = (float*)(shm + OFF_TOT);
    u32x4 rb_[4], rx_[8];
#pragma unroll
    for (int q = 0; q < 4; ++q) { const int sgi = tid + q * NTHREADS; rb_[q] = *(const u32x4*)(XC + (r0 + (sgi >> 4)) * 1024 + 512 + g * 128 + (sgi & 15) * 8); }
#pragma unroll
    for (int q = 0; q < 8; ++q) { const int sgi = tid + q * NTHREADS; rx_[q] = *(const u32x4*)(XC + (r0 + (sgi >> 5)) * 1024 + g * 256 + (sgi & 31) * 8); }
    chunk_cums(a, l, b, c, g, shm, tid);
#pragma unroll
    for (int q = 0; q < 4; ++q) { const int sgi = tid + q * NTHREADS; const int j = sgi >> 4, n0 = (sgi & 15) * 8;
        *(u32x4*)(shm + (j >> 6) * 16384 + att::v_st(j & 63, n0)) = rb_[q]; }
    __syncthreads();
    const int h4 = wid >> 1, nhalf = wid & 1, head = g * 4 + h4;
    bf16_t* SST = (bf16_t*)(a->ws + WS_SST); float* CD = (float*)(a->ws + WS_CD);
    for (int dir = 0; dir < 2; ++dir) {
#pragma unroll
        for (int q = 0; q < 8; ++q) { const int sgi = tid + q * NTHREADS; const int j = sgi >> 5, c0 = (sgi & 31) * 8; const int hh = c0 >> 6;
            const u32x4 v = rx_[q];
            const int wq = hh * 2 + dir; const float u = __expf(tot[wq] - cum[wq * 128 + j]) * dts[wq * 128 + j];
            u32x4 o;
#pragma unroll
            for (int e = 0; e < 4; ++e) o[e] = cvtpk(lo_bf(v[e]) * u, hi_bf(v[e]) * u);
            *(u32x4*)(shm + 32768 + ((j >> 6) * 2 + (c0 >> 7)) * 16384 + att::v_st(j & 63, c0 & 127)) = o; }
        __syncthreads();
        f32x16 acc[2][2] = {};
        const int vbase = (int)(uintptr_t)shm + att::v_rd_base(lane);
#pragma unroll
        for (int kt = 0; kt < 2; ++kt) {
            const int vbB = vbase + kt * 16384 + (nhalf * 2) * 512;
            const int vbX = vbase + 32768 + (kt * 2 + (h4 >> 1)) * 16384 + ((h4 & 1) * 2) * 512;
#define S1_STEP(KS) { const s16x4 bl0 = att::tr_read<KS * 4096>(vbB), bh0 = att::tr_read<KS * 4096 + 2048>(vbB), bl1 = att::tr_read<KS * 4096>(vbB + 512), bh1 = att::tr_read<KS * 4096 + 2048>(vbB + 512); \
            const s16x4 xl0 = att::tr_read<KS * 4096>(vbX), xh0 = att::tr_read<KS * 4096 + 2048>(vbX), xl1 = att::tr_read<KS * 4096>(vbX + 512), xh1 = att::tr_read<KS * 4096 + 2048>(vbX + 512); \
            asm volatile("s_waitcnt lgkmcnt(0)" ::: "memory"); __builtin_amdgcn_sched_barrier(0); \
            const bf16x8 fb0 = S1_PK(bl0, bh0), fb1 = S1_PK(bl1, bh1), fx0 = S1_PK(xl0, xh0), fx1 = S1_PK(xl1, xh1); \
            acc[0][0] = __builtin_amdgcn_mfma_f32_32x32x16_bf16(fb0, fx0, acc[0][0], 0, 0, 0); acc[0][1] = __builtin_amdgcn_mfma_f32_32x32x16_bf16(fb0, fx1, acc[0][1], 0, 0, 0); \
            acc[1][0] = __builtin_amdgcn_mfma_f32_32x32x16_bf16(fb1, fx0, acc[1][0], 0, 0, 0); acc[1][1] = __builtin_amdgcn_mfma_f32_32x32x16_bf16(fb1, fx1, acc[1][1], 0, 0, 0); }
#define S1_PK(L, H) (bf16x8){L[0], L[1], L[2], L[3], H[0], H[1], H[2], H[3]}
            S1_STEP(0) S1_STEP(1) S1_STEP(2) S1_STEP(3)
#undef S1_STEP
#undef S1_PK
        }
        bf16_t* Sp = SST + st_index(b, dir, c, head);
#pragma unroll
        for (int nb = 0; nb < 2; ++nb)
#pragma unroll
            for (int pb = 0; pb < 2; ++pb) { const int p = pb * 32 + r32;
#pragma unroll
                for (int t = 0; t < 2; ++t) { const int n0 = nhalf * 64 + nb * 32 + 16 * t + 8 * hi; const f32x16& v = acc[nb][pb];
                    const u32x2 A = {cvtpk(v[8 * t], v[8 * t + 1]), cvtpk(v[8 * t + 2], v[8 * t + 3])}, B = {cvtpk(v[8 * t + 4], v[8 * t + 5]), cvtpk(v[8 * t + 6], v[8 * t + 7])};
                    *(u32x4*)(Sp + p * 128 + n0) = pair16(A, B); } }
        if (nhalf == 0 && lane == 0) CD[((b * 2 + dir) * NCH + c) * 8 + head] = __expf(tot[h4 * 2 + dir]);
        __syncthreads();
    }
}
__device__ __forceinline__ void s2_scan(KArgs a) {
    bf16_t* SST = (bf16_t*)(a->ws + WS_SST); const float* CD = (const float*)(a->ws + WS_CD);
    const int gt = blockIdx.x * NTHREADS + ltid();
    for (int e = gt; e < NB * 2 * 8 * 2048; e += gridDim.x * NTHREADS) {
        const int seg = e & 2047, head = (e >> 11) & 7, dir = (e >> 14) & 1, b = e >> 15;
        float h[4]; float zz = 0.f; asm volatile("" : "+v"(zz));
#pragma unroll
        for (int j = 0; j < 4; ++j) h[j] = zz;
        for (int k0 = 0; k0 < NCH; k0 += 4) { u32x2 sv[4]; float d[4]; bf16_t* p[4];
#pragma unroll
            for (int q = 0; q < 4; ++q) { const int k = k0 + q < NCH ? k0 + q : NCH - 1; const int c = dir == 0 ? k : (k < 2 ? 1 - k : NCH + 1 - k);
                p[q] = SST + st_index(b, dir, c, head) + seg * 4; sv[q] = *(const u32x2*)p[q]; d[q] = CD[((b * 2 + dir) * NCH + c) * 8 + head]; }
#pragma unroll
            for (int q = 0; q < 4; ++q) if (k0 + q < NCH) {
                u32x2 o = {cvtpk(h[0], h[1]), cvtpk(h[2], h[3])}; *(u32x2*)p[q] = o;
#pragma unroll
                for (int j = 0; j < 2; ++j) { h[2 * j] = d[q] * h[2 * j] + lo_bf(sv[q][j]); h[2 * j + 1] = d[q] * h[2 * j + 1] + hi_bf(sv[q][j]); } } }
    }
}
template <int HP> __device__ __forceinline__ void pv2(f32x16* od, int vb, bf16x8 pa0, bf16x8 pa1, bf16x8 pa2, bf16x8 pa3) {
    att::pv_oneT<HP * 2>(od[0], vb, pa0, pa1, pa2, pa3); att::pv_oneT<HP * 2 + 1>(od[1], vb, pa0, pa1, pa2, pa3);
}
__device__ __forceinline__ void s3_unit(KArgs a, int l, int b, int c, int g, char* shm) {
    const int tid = ltid(), wid = tid >> 6, lane = tid & 63, r32 = lane & 31, hi = lane >> 5;
    const bf16_t* XC = (const bf16_t*)(a->ws + WS_XBCC); const size_t r0 = (size_t)b * SEQ + c * 128;
    float* cum = (float*)(shm + OFF_CUM); float* dts = (float*)(shm + OFF_DT); float* ssq = (float*)(shm + OFF_SSQ);
    chunk_cums(a, l, b, c, g, shm, tid);
#pragma unroll
    for (int q = 0; q < 4; ++q) { const int sgi = tid + q * NTHREADS; const int j = sgi >> 4, n0 = (sgi & 15) * 8;
        const u32x4 v = *(const u32x4*)(XC + (r0 + j) * 1024 + 512 + g * 128 + n0);
        *(u32x4*)(shm + (j >> 6) * 16384 + KSWZ(j & 63, n0 * 2)) = v; }
#pragma unroll
    for (int q = 0; q < 8; ++q) { const int sgi = tid + q * NTHREADS; const int j = sgi >> 5, c0 = (sgi & 31) * 8;
        const u32x4 v = *(const u32x4*)(XC + (r0 + j) * 1024 + g * 256 + c0);
        *(u32x4*)(shm + 32768 + ((j >> 6) * 2 + (c0 >> 7)) * 16384 + att::v_st(j & 63, c0 & 127)) = v; }
#pragma unroll
    for (int q = 0; q < 4; ++q) { const int sgi = tid + q * NTHREADS; const int j = sgi >> 4, n0 = (sgi & 15) * 8;
        const u32x4 v = *(const u32x4*)(XC + (r0 + j) * 1024 + 768 + g * 128 + n0);
        *(u32x4*)(shm + 98304 + (j >> 6) * 16384 + KSWZ(j & 63, n0 * 2)) = v; }
    __syncthreads();
    const int h4 = wid >> 1, ihalf = wid & 1, head = g * 4 + h4;
    const bf16_t* SST = (const bf16_t*)(a->ws + WS_SST); bf16_t* Z = (bf16_t*)(a->ws + WS_Z);
    const float Dh = a->in[13][l * 8 + head]; const float* nw = a->in[14] + l * 512 + head * 64;
    const int vbase = (int)(uintptr_t)shm + att::v_rd_base(lane) + 32768 + (h4 >> 1) * 16384;
    for (int ib = ihalf * 2; ib < ihalf * 2 + 2; ++ib) {
        const int irow = ib * 32 + r32;
        bf16x8 qr[8];
#pragma unroll
        for (int d0 = 0; d0 < 8; ++d0) qr[d0] = *(const bf16x8*)(shm + 98304 + (irow >> 6) * 16384 + KSWZ(irow & 63, (d0 * 16 + hi * 8) * 2));
        f32x16 od[2] = {};
        for (int dir = 0; dir < 2; ++dir) {
            const float* cm = cum + (h4 * 2 + dir) * 128; const float* dd = dts + (h4 * 2 + dir) * 128; const float ci = cm[irow];
            bf16x8 hf0[8], hf1[8];
            {   const bf16_t* Hp = SST + st_index(b, dir, c, head) + (size_t)r32 * 128 + hi * 8;
#pragma unroll
                for (int d0 = 0; d0 < 8; ++d0) { hf0[d0] = *(const bf16x8*)(Hp + d0 * 16); hf1[d0] = *(const bf16x8*)(Hp + 32 * 128 + d0 * 16); } }
            for (int kt = 0; kt < 2; ++kt) {
                if (dir == 0 ? (kt * 64 > ib * 32 + 31) : (kt * 64 + 63 < ib * 32)) continue;
                f32x16 p0, p1; att::qkt(p0, p1, (const bf16_t*)(shm + kt * 16384), qr, r32, hi);
                int ir = dir == 0 ? irow : -irow; asm volatile("" : "+v"(ir));
#pragma unroll
                for (int r = 0; r < 16; ++r) { const int j0 = kt * 64 + att::crow(r, hi), j1 = j0 + 32;
                    const bool k0 = (dir == 0 ? j0 : -j0) <= ir, k1 = (dir == 0 ? j1 : -j1) <= ir;
                    p0[r] = k0 ? p0[r] * __expf(fminf(ci - cm[j0], 0.f)) * dd[j0] : 0.f; p1[r] = k1 ? p1[r] * __expf(fminf(ci - cm[j1], 0.f)) * dd[j1] : 0.f; }
                bf16x8 pa0, pa1, pa2, pa3;
#define PK4(P, BASE, OUT) do { unsigned a0 = cvtpk_asm(P[BASE + 0], P[BASE + 1]), a1 = cvtpk_asm(P[BASE + 2], P[BASE + 3]);   \
    unsigned b0 = cvtpk_asm(P[BASE + 4], P[BASE + 5]), b1 = cvtpk_asm(P[BASE + 6], P[BASE + 7]);                              \
    auto rr0 = __builtin_amdgcn_permlane32_swap(a0, b0, false, false); auto rr1 = __builtin_amdgcn_permlane32_swap(a1, b1, false, false); \
    u32x4 w_ = {rr0[0], rr1[0], rr0[1], rr1[1]}; OUT = *reinterpret_cast<bf16x8*>(&w_); } while (0)
                PK4(p0, 0, pa0); PK4(p0, 8, pa1); PK4(p1, 0, pa2); PK4(p1, 8, pa3);
#undef PK4
                __builtin_amdgcn_sched_barrier(0);
                if (h4 & 1) pv2<1>(od, vbase + kt * 32768, pa0, pa1, pa2, pa3); else pv2<0>(od, vbase + kt * 32768, pa0, pa1, pa2, pa3);
            }
            f32x16 of0 = {}, of1 = {};
#pragma unroll
            for (int d0 = 0; d0 < 8; ++d0) { of0 = __builtin_amdgcn_mfma_f32_32x32x16_bf16(hf0[d0], qr[d0], of0, 0, 0, 0); of1 = __builtin_amdgcn_mfma_f32_32x32x16_bf16(hf1[d0], qr[d0], of1, 0, 0, 0); }
            {   const float e = __expf(ci);
#pragma unroll
                for (int r = 0; r < 16; ++r) { od[0][r] += e * of0[r]; od[1][r] += e * of1[r]; } }
        }
        {   const size_t row = r0 + irow; const int cb = head * 64 + 4 * hi;
            u32x2 xv[2][4], zv[2][4]; f32x4 nv[2][4];
#pragma unroll
            for (int pb = 0; pb < 2; ++pb)
#pragma unroll
                for (int q = 0; q < 4; ++q) { const int col = cb + pb * 32 + 8 * q; xv[pb][q] = *(const u32x2*)(XC + row * 1024 + col); zv[pb][q] = *(const u32x2*)(Z + row * 512 + col); nv[pb][q] = *(const f32x4*)(nw + (col - head * 64)); }
            float sq = 0.f;
#pragma unroll
            for (int pb = 0; pb < 2; ++pb)
#pragma unroll
                for (int q = 0; q < 4; ++q) { const int col = cb + pb * 32 + 8 * q;
                    const float y0 = (od[pb][4 * q] + Dh * lo_bf(xv[pb][q][0])) * siluf_(lo_bf(zv[pb][q][0])), y1 = (od[pb][4 * q + 1] + Dh * hi_bf(xv[pb][q][0])) * siluf_(hi_bf(zv[pb][q][0]));
                    const float y2 = (od[pb][4 * q + 2] + Dh * lo_bf(xv[pb][q][1])) * siluf_(lo_bf(zv[pb][q][1])), y3 = (od[pb][4 * q + 3] + Dh * hi_bf(xv[pb][q][1])) * siluf_(hi_bf(zv[pb][q][1]));
                    sq += y0 * y0 + y1 * y1 + y2 * y2 + y3 * y3;
                    u32x2 w = {cvtpk(y0 * nv[pb][q][0], y1 * nv[pb][q][1]), cvtpk(y2 * nv[pb][q][2], y3 * nv[pb][q][3])}; *(u32x2*)(Z + row * 512 + col) = w; }
            sq += __shfl_xor(sq, 32, 64);
            if (hi == 0) ssq[h4 * 128 + irow] = sq; }
    }
    __syncthreads();
    if (tid < 128) ((float*)(a->ws + WS_SSQ))[(r0 + tid) * 2 + g] = (ssq[tid] + ssq[128 + tid]) + (ssq[256 + tid] + ssq[384 + tid]);
    __syncthreads();
}
}


namespace gla {
constexpr int NCH = SEQ / 64;
constexpr int OFF_GC = 65536;
constexpr int OFF_SSQ = OFF_GC + 32768;
constexpr int OFF_SEG = OFF_SSQ + 1024;
__device__ __forceinline__ bf16_t* st_ptr(KArgs a, int b, int dir, int c, int head) {
    return (bf16_t*)(a->ws + (dir ? WS_GST1 : WS_GST0)) + ((size_t)((b * NCH + c) * 4 + head)) * 16384; }
__device__ __forceinline__ float* tot_ptr(KArgs a, int b, int dir, int c, int head) { return (float*)(a->ws + WS_GTOT) + ((size_t)(((b * 2 + dir) * NCH + c) * 4 + head)) * 128; }
struct Ld2 { u32x4 v[2]; };
__device__ __forceinline__ Ld2 ld_tile(const bf16_t* base, int ld, size_t r0, int tid) { Ld2 o;
#pragma unroll
    for (int q = 0; q < 2; ++q) { const int sgi = tid + q * NTHREADS; o.v[q] = *(const u32x4*)(base + (r0 + (sgi >> 4)) * ld + (sgi & 15) * 8); }
    return o; }
struct GateOp { bf16x8 a[2], b[2]; float gb[2]; };
__device__ __forceinline__ GateOp ld_gate(KArgs a, int l, size_t r0, int head, int tid) { GateOp o;
    const int wid = tid >> 6, lane = tid & 63, r32 = lane & 31, hi = lane >> 5, rb = wid >> 2, cbk = wid & 3;
    const float* SM = (const float*)(a->ws + WS_SM); const bf16_t* G2T = (const bf16_t*)(a->ws + WS_G2T); const int kc = head * 128 + cbk * 32 + r32;
#pragma unroll
    for (int d = 0; d < 2; ++d) { const float* gp = SM + (r0 + rb * 32 + r32) * 48 + 16 + d * 16 + hi * 8; const f32x4 x0 = *(const f32x4*)gp, x1 = *(const f32x4*)(gp + 4);
        u32x4 w = {cvtpk(x0[0], x0[1]), cvtpk(x0[2], x0[3]), cvtpk(x1[0], x1[1]), cvtpk(x1[2], x1[3])}; o.a[d] = *reinterpret_cast<bf16x8*>(&w);
        o.b[d] = *(const bf16x8*)(G2T + ((size_t)d * 512 + kc) * 16 + hi * 8); o.gb[d] = a->in[16][(l * 2 + d) * 512 + kc]; }
    return o; }
__device__ __forceinline__ void make_gc(const GateOp& go, int dir, char* shm, int tid) {
    float* gc = (float*)(shm + OFF_GC); float* seg = (float*)(shm + OFF_SEG);
    {   const int wid = tid >> 6, lane = tid & 63, r32 = lane & 31, hi = lane >> 5, rb = wid >> 2, cbk = wid & 3;
        f32x16 lg = {}; lg = __builtin_amdgcn_mfma_f32_32x32x16_bf16(go.a[dir], go.b[dir], lg, 0, 0, 0);
#pragma unroll
        for (int r = 0; r < 16; ++r) gc[(rb * 32 + att::crow(r, hi)) * 128 + cbk * 32 + r32] = -softplus_fast(-(lg[r] + go.gb[dir])) * 0.0625f; }
    __syncthreads();
    const int k = tid & 127, sg = tid >> 7; float v[16]; float acc = 0.f;
#pragma unroll
    for (int i = 0; i < 16; ++i) { const int w = sg * 16 + i; const int l = dir ? 63 - w : w; acc += gc[l * 128 + k]; v[i] = acc; }
    seg[sg * 128 + k] = acc;
    __syncthreads();
    float off = 0.f;
#pragma unroll
    for (int j = 0; j < 3; ++j) off += j < sg ? seg[j * 128 + k] : 0.f;
#pragma unroll
    for (int i = 0; i < 16; ++i) { const int w = sg * 16 + i; const int l = dir ? 63 - w : w; gc[l * 128 + k] = v[i] + off; }
    __syncthreads();
}
__device__ __forceinline__ void g1_unit(KArgs a, int l_, int b, int c, int head, char* shm) {
    const int tid = ltid(), wid = tid >> 6, lane = tid & 63, r32 = lane & 31, hi = lane >> 5;
    const bf16_t* GK = (const bf16_t*)(a->ws + WS_GK); const bf16_t* GV = (const bf16_t*)(a->ws + WS_GV); const size_t r0 = (size_t)b * SEQ + c * 64;
    const float* gc = (const float*)(shm + OFF_GC);
    const Ld2 rv = ld_tile(GV + head * 128, 512, r0, tid), rk = ld_tile(GK + head * 128, 512, r0, tid);
    const GateOp go = ld_gate(a, l_, r0, head, tid);
#pragma unroll
    for (int q = 0; q < 2; ++q) { const int sgi = tid + q * NTHREADS; *(u32x4*)(shm + 16384 + att::v_st(sgi >> 4, (sgi & 15) * 8)) = rv.v[q]; }
    for (int dir = 0; dir < 2; ++dir) {
        make_gc(go, dir, shm, tid);
        const int lt = dir == 0 ? 63 : 0;
        if (tid < 128) tot_ptr(a, b, dir, c, head)[tid] = gc[lt * 128 + tid];
#pragma unroll
        for (int q = 0; q < 2; ++q) { const int sgi = tid + q * NTHREADS; const int l = sgi >> 4, k0 = (sgi & 15) * 8;
            const u32x4 kv = rk.v[q]; const float* gl = gc + l * 128 + k0; const float* gt = gc + lt * 128 + k0;
            u32x4 o;
#pragma unroll
            for (int e = 0; e < 4; ++e) o[e] = cvtpk(lo_bf(kv[e]) * __expf(gt[2 * e] - gl[2 * e]), hi_bf(kv[e]) * __expf(gt[2 * e + 1] - gl[2 * e + 1]));
            *(u32x4*)(shm + att::v_st(l, k0)) = o; }
        __syncthreads();
        const int kb = wid >> 1, vb0 = (wid & 1) * 2;
        f32x16 acc0 = {}, acc1 = {};
        const int vbase = (int)(uintptr_t)shm + att::v_rd_base(lane);
        const int vbK = vbase + kb * 512, vbV = vbase + 16384 + vb0 * 512;
#define G1_STEP(KS) { const s16x4 kl = att::tr_read<KS * 4096>(vbK), kh = att::tr_read<KS * 4096 + 2048>(vbK); \
            const s16x4 al = att::tr_read<KS * 4096>(vbV), ah = att::tr_read<KS * 4096 + 2048>(vbV), bl = att::tr_read<KS * 4096>(vbV + 512), bh = att::tr_read<KS * 4096 + 2048>(vbV + 512); \
            asm volatile("s_waitcnt lgkmcnt(0)" ::: "memory"); __builtin_amdgcn_sched_barrier(0); \
            const bf16x8 fk = G1_PK(kl, kh), fa = G1_PK(al, ah), fb = G1_PK(bl, bh); \
            acc0 = __builtin_amdgcn_mfma_f32_32x32x16_bf16(fk, fa, acc0, 0, 0, 0); acc1 = __builtin_amdgcn_mfma_f32_32x32x16_bf16(fk, fb, acc1, 0, 0, 0); }
#define G1_PK(L, H) (bf16x8){L[0], L[1], L[2], L[3], H[0], H[1], H[2], H[3]}
        G1_STEP(0) G1_STEP(1) G1_STEP(2) G1_STEP(3)
#undef G1_STEP
#undef G1_PK
        bf16_t* Sp = st_ptr(a, b, dir, c, head);
#pragma unroll
        for (int t = 0; t < 2; ++t) { const f32x16& v = t ? acc1 : acc0; const int vv = (vb0 + t) * 32 + r32;
#pragma unroll
            for (int t2 = 0; t2 < 2; ++t2) { const int k0 = kb * 32 + 16 * t2 + 8 * hi;
                const u32x2 A = {cvtpk(v[8 * t2], v[8 * t2 + 1]), cvtpk(v[8 * t2 + 2], v[8 * t2 + 3])}, B = {cvtpk(v[8 * t2 + 4], v[8 * t2 + 5]), cvtpk(v[8 * t2 + 6], v[8 * t2 + 7])};
                *(u32x4*)(Sp + vv * 128 + k0) = pair16(A, B); } }
        __syncthreads();
    }
}
__device__ __forceinline__ void g2_scan(KArgs a) {
    const int gt = blockIdx.x * NTHREADS + ltid();
    for (int e = gt; e < NB * 2 * 4 * 4096; e += gridDim.x * NTHREADS) {
        const int seg = e & 4095, head = (e >> 12) & 3, dir = (e >> 14) & 1, b = e >> 15; const int kk = (seg & 31) * 4;
        float h[4]; float zz = 0.f; asm volatile("" : "+v"(zz));
#pragma unroll
        for (int j = 0; j < 4; ++j) h[j] = zz;
        for (int k0 = 0; k0 < NCH; k0 += 4) { u32x2 sv[4]; f32x4 t0[4]; bf16_t* p[4];
#pragma unroll
            for (int q = 0; q < 4; ++q) { const int k = k0 + q; const int c = dir == 0 ? k : (k < 4 ? 3 - k : NCH + 3 - k);
                p[q] = st_ptr(a, b, dir, c, head) + seg * 4; sv[q] = *(const u32x2*)p[q]; t0[q] = *(const f32x4*)(tot_ptr(a, b, dir, c, head) + kk); }
#pragma unroll
            for (int q = 0; q < 4; ++q) {
                u32x2 o = {cvtpk(h[0], h[1]), cvtpk(h[2], h[3])}; *(u32x2*)p[q] = o;
#pragma unroll
                for (int j = 0; j < 2; ++j) { h[2 * j] = __expf(t0[q][2 * j]) * h[2 * j] + lo_bf(sv[q][j]); h[2 * j + 1] = __expf(t0[q][2 * j + 1]) * h[2 * j + 1] + hi_bf(sv[q][j]); } } }
    }
}
template <int VB> __device__ __forceinline__ void pv1(f32x16& od, int vb, bf16x8 pa0, bf16x8 pa1, bf16x8 pa2, bf16x8 pa3) { att::pv_oneT<VB>(od, vb, pa0, pa1, pa2, pa3); }
__device__ __forceinline__ void g3_unit(KArgs a, int l_, int b, int c, int head, char* shm) {
    const int tid = ltid(), wid = tid >> 6, lane = tid & 63, r32 = lane & 31, hi = lane >> 5;
    const bf16_t* GQ = (const bf16_t*)(a->ws + WS_GQ); const bf16_t* GK = (const bf16_t*)(a->ws + WS_GK); const bf16_t* GV = (const bf16_t*)(a->ws + WS_GV);
    bf16_t* GR = (bf16_t*)(a->ws + WS_GR); const size_t r0 = (size_t)b * SEQ + c * 64;
    const float* gc = (const float*)(shm + OFF_GC); float* ssq = (float*)(shm + OFF_SSQ);
    const Ld2 rvt = ld_tile(GV + head * 128, 512, r0, tid), rq = ld_tile(GQ + head * 128, 512, r0, tid), rk = ld_tile(GK + head * 128, 512, r0, tid);
    const GateOp go = ld_gate(a, l_, r0, head, tid);
#pragma unroll
    for (int q = 0; q < 2; ++q) { const int sgi = tid + q * NTHREADS; *(u32x4*)(shm + 49152 + att::v_st(sgi >> 4, (sgi & 15) * 8)) = rvt.v[q]; }
    const int ib = wid >> 2, vb = wid & 3;
    f32x16 od = {};
    for (int dir = 0; dir < 2; ++dir) {
        bf16x8 sbf[8];
        {   const bf16_t* Sp = st_ptr(a, b, dir, c, head) + (size_t)(vb * 32 + r32) * 128 + hi * 8;
#pragma unroll
            for (int d0 = 0; d0 < 8; ++d0) sbf[d0] = *(const bf16x8*)(Sp + d0 * 16); }
        make_gc(go, dir, shm, tid);
        const int lref = dir == 0 ? 32 : 31;
#pragma unroll
        for (int q = 0; q < 2; ++q) { const int sgi = tid + q * NTHREADS; const int l = sgi >> 4, k0 = (sgi & 15) * 8;
            const u32x4 kv = rk.v[q], qv = rq.v[q];
            const float* gl = gc + l * 128 + k0; const float* gr_ = gc + lref * 128 + k0;
            u32x4 ok, oq, ot;
#pragma unroll
            for (int e = 0; e < 4; ++e) { const float d0 = gl[2 * e] - gr_[2 * e], d1 = gl[2 * e + 1] - gr_[2 * e + 1];
                ok[e] = cvtpk(lo_bf(kv[e]) * __expf(-d0), hi_bf(kv[e]) * __expf(-d1));
                oq[e] = cvtpk(lo_bf(qv[e]) * __expf(d0), hi_bf(qv[e]) * __expf(d1));
                ot[e] = cvtpk(lo_bf(qv[e]) * __expf(gl[2 * e]), hi_bf(qv[e]) * __expf(gl[2 * e + 1])); }
            const int sw = KSWZ(l, k0 * 2);
            *(u32x4*)(shm + sw) = ok; *(u32x4*)(shm + 16384 + sw) = oq; *(u32x4*)(shm + 32768 + sw) = ot; }
        __syncthreads();
        {   bf16x8 qr[8];
#pragma unroll
            for (int d0 = 0; d0 < 8; ++d0) qr[d0] = *(const bf16x8*)(shm + 16384 + KSWZ(ib * 32 + r32, (d0 * 16 + hi * 8) * 2));
            f32x16 p0, p1; att::qkt(p0, p1, (const bf16_t*)shm, qr, r32, hi);
            int ir = dir == 0 ? (ib * 32 + r32) : -(ib * 32 + r32); asm volatile("" : "+v"(ir));
#pragma unroll
            for (int r = 0; r < 16; ++r) { const int j0 = att::crow(r, hi), j1 = j0 + 32;
                p0[r] = ((dir == 0 ? j0 : -j0) <= ir) ? p0[r] : 0.f; p1[r] = ((dir == 0 ? j1 : -j1) <= ir) ? p1[r] : 0.f; }
            bf16x8 pa0, pa1, pa2, pa3;
#define PK4(P, BASE, OUT) do { unsigned a0 = cvtpk_asm(P[BASE + 0], P[BASE + 1]), a1 = cvtpk_asm(P[BASE + 2], P[BASE + 3]);   \
    unsigned b0 = cvtpk_asm(P[BASE + 4], P[BASE + 5]), b1 = cvtpk_asm(P[BASE + 6], P[BASE + 7]);                              \
    auto rr0 = __builtin_amdgcn_permlane32_swap(a0, b0, false, false); auto rr1 = __builtin_amdgcn_permlane32_swap(a1, b1, false, false); \
    u32x4 w_ = {rr0[0], rr1[0], rr0[1], rr1[1]}; OUT = *reinterpret_cast<bf16x8*>(&w_); } while (0)
            PK4(p0, 0, pa0); PK4(p0, 8, pa1); PK4(p1, 0, pa2); PK4(p1, 8, pa3);
#undef PK4
            __builtin_amdgcn_sched_barrier(0);
            const int vbb = (int)(uintptr_t)shm + att::v_rd_base(lane) + 49152;
            if (vb == 0) pv1<0>(od, vbb, pa0, pa1, pa2, pa3); else if (vb == 1) pv1<1>(od, vbb, pa0, pa1, pa2, pa3);
            else if (vb == 2) pv1<2>(od, vbb, pa0, pa1, pa2, pa3); else pv1<3>(od, vbb, pa0, pa1, pa2, pa3);
        }
        {
#pragma unroll
            for (int d0 = 0; d0 < 8; ++d0) { const bf16x8 qa = *(const bf16x8*)(shm + 32768 + KSWZ(ib * 32 + r32, (d0 * 16 + hi * 8) * 2));
                od = __builtin_amdgcn_mfma_f32_32x32x16_bf16(sbf[d0], qa, od, 0, 0, 0); } }
        __syncthreads();
    }
    const float qs = 0.08838834764831845f; const int irow = ib * 32 + r32; const size_t row = r0 + irow; const int cb = head * 128 + vb * 32 + 4 * hi;
    float sq = 0.f;
#pragma unroll
    for (int r = 0; r < 16; ++r) { od[r] *= qs; sq += od[r] * od[r]; }
    sq += __shfl_xor(sq, 32, 64);
    if (hi == 0) ssq[vb * 64 + irow] = sq;
    u32x2 rv[4]; f32x4 nv[4];
#pragma unroll
    for (int q = 0; q < 4; ++q) { rv[q] = *(const u32x2*)(GR + row * 512 + cb + 8 * q); nv[q] = *(const f32x4*)(a->in[17] + l_ * 512 + cb + 8 * q); }
    __syncthreads();
    const float inv = rsqrtf(((ssq[irow] + ssq[64 + irow]) + (ssq[128 + irow] + ssq[192 + irow])) * (1.f / 128.f) + EPS);
#pragma unroll
    for (int q = 0; q < 4; ++q) {
        u32x2 w = {cvtpk(od[4 * q] * inv * nv[q][0] * siluf_(lo_bf(rv[q][0])), od[4 * q + 1] * inv * nv[q][1] * siluf_(hi_bf(rv[q][0]))),
                   cvtpk(od[4 * q + 2] * inv * nv[q][2] * siluf_(lo_bf(rv[q][1])), od[4 * q + 3] * inv * nv[q][3] * siluf_(hi_bf(rv[q][1])))};
        *(u32x2*)(GR + row * 512 + cb + 8 * q) = w; }
    __syncthreads();
}
}

__device__ __forceinline__ void ph_mix(KArgs a, int l, char* shm) {
    const int natt = l == 0 ? 272 : 256;
    const bf16_t* AQ = (const bf16_t*)(a->ws + WS_AQ); const bf16_t* AK = (const bf16_t*)(a->ws + WS_AK); const bf16_t* AV = (const bf16_t*)(a->ws + WS_AV);
    for (int u = blockIdx.x; u < natt + 272 + 1088; u += gridDim.x) {
        if (u < natt) { const int v = u;
            if (v < 256) { const int b = v >> 6, hd = (v >> 4) & 3, qb = v & 15; const size_t r0 = (size_t)b * SEQ;
                att::attn_dense_body(AQ + (r0 + CTX + qb * 256) * 512 + hd * 128, AK + r0 * 256 + (hd >> 1) * 128, AV + r0 * 256 + (hd >> 1) * 128,
                                     (bf16_t*)AQ + (r0 + CTX + qb * 256) * 512 + hd * 128, SEQ, shm); }
            else { const int w = v - 256; const int b = w >> 2, hd = w & 3; const size_t r0 = (size_t)b * SEQ;
                att::attn_dense_body(AQ + r0 * 512 + hd * 128, AK + r0 * 256 + (hd >> 1) * 128, AV + r0 * 256 + (hd >> 1) * 128, (bf16_t*)AQ + r0 * 512 + hd * 128, CTX, shm); } }
        else if (u < natt + 272) { const int v = u - natt; const int b = v / 68, rem = v % 68; ssd::s1_unit(a, l, b, rem >> 1, rem & 1, shm); }
        else { const int v = u - natt - 272; const int b = v / 272, rem = v % 272; gla::g1_unit(a, l, b, rem >> 2, rem & 3, shm); }
    }
}
__device__ __forceinline__ void ph_ssd3(KArgs a, int l, char* shm) {
    const int nu = l == 0 ? 272 : 256;
    for (int k = blockIdx.x; k < nu; k += gridDim.x) { int b, rem; if (l == 0) { b = k / 68; rem = k % 68; } else { b = k >> 6; rem = (k & 63) + 4; }
        ssd::s3_unit(a, l, b, rem >> 1, rem & 1, shm); }
}
__device__ __forceinline__ void ph_gla3(KArgs a, int l, char* shm) {
    const int nu = l == 0 ? 1088 : 1024; const int G = gridDim.x, bx = blockIdx.x;
    const int fb = (l == 0 && G > 32) ? 16 : 0;
    if (bx < fb) return;
    for (int k = bx - fb; k < nu; k += G - fb) { int b, rem; if (l == 0) { b = k / 272; rem = k % 272; } else { b = k >> 8; rem = (k & 255) + 16; }
        gla::g3_unit(a, l, b, rem >> 2, rem & 3, shm); }
}

__device__ __forceinline__ void ph_merge(KArgs a, int l, char* shm) {
    int R0, C0; stage_coords(R0, C0);
    const int nrt = n_row_tiles(l); const int nu = nrt * 4; const int G = gridDim.x, bx = blockIdx.x;
    bf16_t* ACC = (bf16_t*)(a->ws + WS_H);
    const int ntile = bx < nu ? (nu - bx + G - 1) / G : 0;
    gemm_stream<AMapId>(512, ntile * 4,
      [&](int kk, const bf16_t*& A, const bf16_t*& B, AMapId& am, unsigned& bo) { const int u = xcd_unit(kk >> 2, nu), n = kk & 3; const int i = u >> 2, j = u & 3; const int rb = row_tile_base(l, i);
          A = (const bf16_t*)(a->ws + (size_t)n * 2 * U); B = (const bf16_t*)(a->ws + WS_WB) + (size_t)n * 1024 * 512; am = AMapId{(rb + R0) * 512 + C0, 512}; bo = (unsigned)((j * 256 + bperm(R0)) * 512 + C0) * 2u; },
      [&](int kk, f32x4 (&acc)[2][2][4][2]) { const int u = xcd_unit(kk >> 2, nu), n = kk & 3; const int i = u >> 2, j = u & 3; const int rb = row_tile_base(l, i); EPI_LANES;
            const bool ge = l == 0 && n == 0 && j < NGE;
            const bf16_t* GT = ge ? (const bf16_t*)(a->ws + WS_GE) : (const bf16_t*)(a->ws + WS_GATES + (size_t)n * 4 * U); const int gld = ge ? NGE * 256 : 1024;
#pragma unroll
            for (int ai = 0; ai < 2; ++ai) {
                u32x4 gw[4][2], old[4][2]; float rs[4];
#pragma unroll
                for (int m = 0; m < 4; ++m) { const int row = rb + ai * 128 + wr * 64 + m * 16 + fr;
                    rs[m] = 1.f; if (n == 0) { const float* sq = (const float*)(a->ws + WS_SSQ) + (size_t)row * 2; rs[m] = rsqrtf((sq[0] + sq[1]) * (1.f / 512.f) + EPS); }
#pragma unroll
                    for (int bj = 0; bj < 2; ++bj) { const int col = j * 256 + bj * 128 + wc * 32 + fq * 8;
                            gw[m][bj] = *(const u32x4*)(GT + (size_t)row * gld + col); const u32x4 ov = *(const u32x4*)(ACC + (size_t)row * 1024 + col); old[m][bj] = n > 0 ? ov : (u32x4){0u, 0u, 0u, 0u}; } }
#pragma unroll
                for (int m = 0; m < 4; ++m) { const int row = rb + ai * 128 + wr * 64 + m * 16 + fr;
#pragma unroll
                    for (int bj = 0; bj < 2; ++bj) { const int col = j * 256 + bj * 128 + wc * 32 + fq * 8; const u32x4 g2 = gw[m][bj], od_ = old[m][bj]; u32x4 w;
#pragma unroll
                        for (int nn = 0; nn < 2; ++nn) { const f32x4 v = acc[ai][bj][m][nn] * rs[m];
                            const float o0 = v[0] * lo_bf(g2[2 * nn]) + lo_bf(od_[2 * nn]), o1 = v[1] * hi_bf(g2[2 * nn]) + hi_bf(od_[2 * nn]), o2 = v[2] * lo_bf(g2[2 * nn + 1]) + lo_bf(od_[2 * nn + 1]), o3 = v[3] * hi_bf(g2[2 * nn + 1]) + hi_bf(od_[2 * nn + 1]);
                            w[2 * nn] = cvtpk(o0, o1); w[2 * nn + 1] = cvtpk(o2, o3); }
                        *(u32x4*)(ACC + (size_t)row * 1024 + col) = w; } }
            }
      }, shm);
}
__device__ __forceinline__ void ph_wout(KArgs a, int l, char* shm) {
    int R0, C0; stage_coords(R0, C0);
    const int nrt = n_row_tiles(l);
    const bf16_t* ACC = (const bf16_t*)(a->ws + WS_H); const bf16_t* W = (const bf16_t*)(a->ws + WS_WO);
    for (int k = 0; ; ++k) { const int u = xcd_unit(k, nrt * 4); if (u >= nrt * 4) break;
        const int i = u >> 2, j = u & 3; const int rb = row_tile_base(l, i);
        f32x4 acc[2][2][4][2];
        AMapId am{(rb + R0) * 1024 + C0, 1024};
        gemm_tile(ACC, W, 1024, am, (j * 256 + bperm(R0)) * 1024 + C0, acc, shm); EPI_LANES;
#pragma unroll
        for (int ai = 0; ai < 2; ++ai)
#pragma unroll
            for (int m = 0; m < 4; ++m) { const int row = rb + ai * 128 + wr * 64 + m * 16 + fr;
                const float* xin = l == 0 ? xrow_in(a, row) : (const float*)xrow(a, row); float* xo = xrow(a, row); const float* g1 = modp(a, l, row, 2);
                f32x4 xi[2][2], gg[2][2];
#pragma unroll
                for (int bj = 0; bj < 2; ++bj)
#pragma unroll
                    for (int nn = 0; nn < 2; ++nn) { const int col = j * 256 + bj * 128 + wc * 32 + fq * 8 + nn * 4; xi[bj][nn] = *(const f32x4*)(xin + col); gg[bj][nn] = *(const f32x4*)(g1 + col); }
#pragma unroll
                for (int bj = 0; bj < 2; ++bj)
#pragma unroll
                    for (int nn = 0; nn < 2; ++nn) { const int col = j * 256 + bj * 128 + wc * 32 + fq * 8 + nn * 4; const f32x4 v = acc[ai][bj][m][nn];
                        *(f32x4*)(xo + col) = xi[bj][nn] + gg[bj][nn] * v; } }
    }
}

__device__ __forceinline__ void ph_norm2(KArgs a, int l, char* shm) {
    float* wrt = (float*)shm;
    const int tid = ltid(), lane = tid & 63, wv = tid >> 6;
    for (int i = tid; i < 4 * 1024; i += NTHREADS) { const int k = i >> 2, j = i & 3; wrt[j * 1024 + k] = a->in[29][(size_t)l * 4096 + i]; }
    for (int i = tid; i < 16 * 1024; i += NTHREADS) { const int k = i >> 4, j = i & 15; wrt[(4 + j) * 1024 + k] = a->in[31][(size_t)l * 16384 + i]; }
    __syncthreads();
    const float* g = a->in[7] + l * 1024; bf16_t* H = (bf16_t*)(a->ws + WS_H);
    int* cnt = (int*)(a->ws + WS_CNT) + l * 16; int* TE = (int*)(a->ws + WS_TOKE); int* TP = (int*)(a->ws + WS_TOKP); float* TW = (float*)(a->ws + WS_TOKW);
    int* lcnt = (int*)(shm + 20 * 1024 * 4); int* lbase = lcnt + 16; int* lrec = lbase + 16;
    float* rbias = (float*)(lrec + 72 * 4);
    if (tid < 16) lcnt[tid] = 0;
    if (tid < 4) rbias[tid] = a->in[30][l * 4 + tid]; else if (tid < 20) rbias[tid] = a->in[32][l * 16 + tid - 4];
    for (int i = tid; i < 72 * 4; i += NTHREADS) lrec[i] = -1;
    __syncthreads();
    auto next_it = [&](int it) { for (; it < 9; ++it) { const int row = blockIdx.x * 8 + wv + it * gridDim.x * 8; if (row >= T) return 9; const int pos = row % SEQ; if (!(l == 1 && pos < CTX)) return it; } return 9; };
    int it = next_it(0); f32x4 v[4];
    {   const float* x = xrow(a, it < 9 ? blockIdx.x * 8 + wv + it * gridDim.x * 8 : 0);
#pragma unroll
        for (int i = 0; i < 4; ++i) v[i] = *(const f32x4*)(x + i * 256 + lane * 4); }
    while (it < 9) { const int row = blockIdx.x * 8 + wv + it * gridDim.x * 8;
        const int nit = next_it(it + 1); f32x4 nv[4];
        const float* sh = modp(a, l, row, 3); const float* sc = modp(a, l, row, 4);
        float ss = 0.f;
#pragma unroll
        for (int i = 0; i < 4; ++i) ss += v[i][0] * v[i][0] + v[i][1] * v[i][1] + v[i][2] * v[i][2] + v[i][3] * v[i][3];
        ss = wave_sum(ss); const float inv = rsqrtf(ss * (1.f / 1024.f) + EPS);
        f32x4 gg[4], s1[4], s0[4];
#pragma unroll
        for (int i = 0; i < 4; ++i) { const int c = i * 256 + lane * 4; gg[i] = *(const f32x4*)(g + c); s1[i] = *(const f32x4*)(sc + c); s0[i] = *(const f32x4*)(sh + c); }
#pragma unroll
        for (int i = 0; i < 4; ++i) { const int c = i * 256 + lane * 4;
#pragma unroll
            for (int j = 0; j < 4; ++j) v[i][j] = v[i][j] * inv * gg[i][j] * (1.f + s1[i][j]) + s0[i][j];
            u32x2 w = {cvtpk(v[i][0], v[i][1]), cvtpk(v[i][2], v[i][3])}; *(u32x2*)(H + (size_t)row * 1024 + c) = w; }
        __builtin_amdgcn_sched_barrier(0);
        { const float* xn = xrow(a, nit < 9 ? blockIdx.x * 8 + wv + nit * gridDim.x * 8 : row);
#pragma unroll
          for (int i = 0; i < 4; ++i) nv[i] = *(const f32x4*)(xn + i * 256 + lane * 4); }
        __builtin_amdgcn_sched_barrier(0);
        float lg[4];
#pragma unroll
        for (int j = 0; j < 4; ++j) { float s = 0.f;
#pragma unroll
            for (int i = 0; i < 4; ++i) { const f32x4 w = *(const f32x4*)(wrt + j * 1024 + i * 256 + lane * 4); s += v[i][0] * w[0] + v[i][1] * w[1] + v[i][2] * w[2] + v[i][3] * w[3]; }
            lg[j] = wave_sum(s) + rbias[j]; }
        int gi = 0; float gm = lg[0];
#pragma unroll
        for (int j = 1; j < 4; ++j) if (lg[j] > gm) { gm = lg[j]; gi = j; }
        float den = 0.f;
#pragma unroll
        for (int j = 0; j < 4; ++j) den += __expf(lg[j] - gm);
        const float pg = 1.f / den;
        float le[4];
#pragma unroll
        for (int j = 0; j < 4; ++j) { float s = 0.f; const float* wp = wrt + (4 + gi * 4 + j) * 1024;
#pragma unroll
            for (int i = 0; i < 4; ++i) { const f32x4 w = *(const f32x4*)(wp + i * 256 + lane * 4); s += v[i][0] * w[0] + v[i][1] * w[1] + v[i][2] * w[2] + v[i][3] * w[3]; }
            le[j] = wave_sum(s) + rbias[4 + gi * 4 + j]; }
        int i1 = 0; float m1 = le[0];
#pragma unroll
        for (int j = 1; j < 4; ++j) if (le[j] > m1) { m1 = le[j]; i1 = j; }
        int i2 = -1; float m2 = -3.0e38f;
#pragma unroll
        for (int j = 0; j < 4; ++j) if (j != i1 && le[j] > m2) { m2 = le[j]; i2 = j; }
        if (i2 < 0) i2 = (i1 + 1) & 3;
        const float e2 = __expf(m2 - m1); const float w1 = 1.f / (1.f + e2), w2 = e2 / (1.f + e2);
        if (lane == 0) {
            const int ea = gi * 4 + i1, eb = gi * 4 + i2;
            const int pa = atomicAdd(&lcnt[ea], 1), pb = atomicAdd(&lcnt[eb], 1);
            TE[row * 2] = ea; TE[row * 2 + 1] = eb; TW[row * 2] = pg * w1; TW[row * 2 + 1] = pg * w2;
            const int sl = it * 8 + wv; lrec[sl * 4] = ea; lrec[sl * 4 + 1] = eb; lrec[sl * 4 + 2] = pa; lrec[sl * 4 + 3] = pb;
        }
#pragma unroll
        for (int i = 0; i < 4; ++i) v[i] = nv[i];
        it = nit;
    }
    __syncthreads();
    if (tid < 16) lbase[tid] = atomicAdd(&cnt[tid], lcnt[tid]);
    __syncthreads();
    if (tid < 72 * 2) { const int sl = tid >> 1, k = tid & 1; const int row = blockIdx.x * 8 + (sl & 7) + (sl >> 3) * gridDim.x * 8;
        if (row < T && lrec[sl * 4] >= 0) { const int e = lrec[sl * 4 + k]; const int p = lbase[e] + lrec[sl * 4 + 2 + k]; TP[row * 2 + k] = p; ((int*)(a->ws + WS_LIST))[e * T + p] = row; } }
}
__device__ __forceinline__ void moe_offsets(KArgs a, int l, int* off  ) {
    if (ltid() == 0) { const int* cnt = (const int*)(a->ws + WS_CNT) + l * 16; int o = 0;
        for (int e = 0; e < 16; ++e) { const int n = __hip_atomic_load(&cnt[e], __ATOMIC_RELAXED, __HIP_MEMORY_SCOPE_AGENT); off[e] = o; off[20 + e] = n; o += ((n + 255) >> 8) << 8; }
        off[16] = o; }
    __syncthreads();
}
__device__ __forceinline__ int moe_expert_of(const int* off, int s0) { int e = 0; for (int q = 1; q < 16; ++q) e = (s0 >= off[q]) ? q : e; return e; }
__device__ __forceinline__ void ph_moe1(KArgs a, int l, char* shm) {
    int* off = (int*)(shm + LDS_MAIN + 16); moe_offsets(a, l, off);
    int R0, C0; stage_coords(R0, C0);
    const bf16_t* H = (const bf16_t*)(a->ws + WS_H); const int* LIST = (const int*)(a->ws + WS_LIST); bf16_t* MA = (bf16_t*)(a->ws + WS_MOEA);
    const int nrt = off[16] >> 8;
    for (int k = 0; ; ++k) { const int u = xcd_unit(k, nrt * 4); if (u >= nrt * 4) break;
        const int i = u >> 2, j = u & 3; const int s0 = i * 256; const int e = moe_expert_of(off, s0);
        AMapG am;
#pragma unroll
        for (int q = 0; q < 4; ++q) { const int p = s0 - off[e] + R0 + 64 * q; const int tk = p < off[20 + e] ? LIST[e * T + p] : 0; am.o[q] = tk * 1024 + C0; }
        f32x4 acc[2][2][4][2];
        gemm_tile(H, (const bf16_t*)(a->ws + WS_E13) + (size_t)e * 1024 * 1024, 1024, am, (j * 256 + R0) * 1024 + C0, acc, shm); EPI_LANES;
#pragma unroll
        for (int ai = 0; ai < 2; ++ai)
#pragma unroll
            for (int m = 0; m < 4; ++m) { const int slot = s0 + ai * 128 + wr * 64 + m * 16 + fr; const int col = j * 128 + wc * 32 + fq * 8;
                const f32x4 p0 = acc[ai][0][m][0], q0 = acc[ai][0][m][1], p1 = acc[ai][1][m][0], q1 = acc[ai][1][m][1];
                u32x4 w = {cvtpk(siluf_(p0[0]) * q0[0], siluf_(p0[1]) * q0[1]), cvtpk(siluf_(p0[2]) * q0[2], siluf_(p0[3]) * q0[3]),
                           cvtpk(siluf_(p1[0]) * q1[0], siluf_(p1[1]) * q1[1]), cvtpk(siluf_(p1[2]) * q1[2], siluf_(p1[3]) * q1[3])};
                *(u32x4*)(MA + (size_t)slot * 512 + col) = w; }
    }
}
__device__ __forceinline__ void ph_moe2(KArgs a, int l, char* shm) {
    int* off = (int*)(shm + LDS_MAIN + 16); moe_offsets(a, l, off);
    int R0, C0; stage_coords(R0, C0);
    const bf16_t* MA = (const bf16_t*)(a->ws + WS_MOEA); bf16_t* MO = (bf16_t*)(a->ws + WS_MOEO);
    const int nrt = off[16] >> 8;
    for (int k = 0; ; ++k) { const int u = xcd_unit(k, nrt * 4); if (u >= nrt * 4) break;
        const int i = u >> 2, j = u & 3; const int s0 = i * 256; const int e = moe_expert_of(off, s0);
        AMapId am{(s0 + R0) * 512 + C0, 512};
        f32x4 acc[2][2][4][2];
        gemm_tile(MA, (const bf16_t*)(a->ws + WS_E2) + (size_t)e * 1024 * 512, 512, am, (j * 256 + bperm(R0)) * 512 + C0, acc, shm); EPI_LANES;
#pragma unroll
        for (int ai = 0; ai < 2; ++ai)
#pragma unroll
            for (int m = 0; m < 4; ++m) { const int slot = s0 + ai * 128 + wr * 64 + m * 16 + fr;
#pragma unroll
                for (int bj = 0; bj < 2; ++bj) { const int col = j * 256 + bj * 128 + wc * 32 + fq * 8; const f32x4 v = acc[ai][bj][m][0], v2 = acc[ai][bj][m][1];
                        u32x4 w = {cvtpk(v[0], v[1]), cvtpk(v[2], v[3]), cvtpk(v2[0], v2[1]), cvtpk(v2[2], v2[3])}; *(u32x4*)(MO + (size_t)slot * 1024 + col) = w; } }
    }
}
__device__ __forceinline__ void moe_row(KArgs a, int l, int row, int lane, const int* off, f32x4 (&o)[4]) {
    const int* TE = (const int*)(a->ws + WS_TOKE); const int* TP = (const int*)(a->ws + WS_TOKP); const float* TW = (const float*)(a->ws + WS_TOKW);
    const bf16_t* MO = (const bf16_t*)(a->ws + WS_MOEO); const float* g2 = modp(a, l, row, 5);
    const int s1 = off[TE[row * 2]] + TP[row * 2], s2 = off[TE[row * 2 + 1]] + TP[row * 2 + 1]; const float w1 = TW[row * 2], w2 = TW[row * 2 + 1];
#pragma unroll
    for (int i = 0; i < 4; ++i) { const int c = i * 256 + lane * 4; const u32x2 p = *(const u32x2*)(MO + (size_t)s1 * 1024 + c), q = *(const u32x2*)(MO + (size_t)s2 * 1024 + c); const f32x4 gg = *(const f32x4*)(g2 + c);
        o[i] = (f32x4){gg[0] * (w1 * lo_bf(p[0]) + w2 * lo_bf(q[0])), gg[1] * (w1 * hi_bf(p[0]) + w2 * hi_bf(q[0])), gg[2] * (w1 * lo_bf(p[1]) + w2 * lo_bf(q[1])), gg[3] * (w1 * hi_bf(p[1]) + w2 * hi_bf(q[1]))}; }
}
__device__ __forceinline__ void ph_final(KArgs a, char* shm) {
    int* off = (int*)(shm + LDS_MAIN + 16); moe_offsets(a, 1, off);
    const int tid = ltid(); const int lane = tid & 63, wv = tid >> 6;
    for (int r = blockIdx.x * 8 + wv; r < NB * LAT; r += gridDim.x * 8) { const int b = r / LAT, t = r - b * LAT; const int row = b * SEQ + CTX + t;
        f32x4 mo[4], xv[4]; moe_row(a, 1, row, lane, off, mo); float* x = a->out + (size_t)r * D;
#pragma unroll
        for (int i = 0; i < 4; ++i) xv[i] = *(const f32x4*)(x + i * 256 + lane * 4);
#pragma unroll
        for (int i = 0; i < 4; ++i) *(f32x4*)(x + i * 256 + lane * 4) = xv[i] + mo[i]; }
}

constexpr int LDS_BYTES = LDS_MAIN + 12288;
constexpr int NPL = 13, NPH = 2 + 2 * NPL;

__global__ void __launch_bounds__(NTHREADS, 2) mk_fwd(Args a_) {
    extern __shared__ __attribute__((aligned(16))) char shm[];
    if (threadIdx.x < 4) ((volatile LAS unsigned*)(shm + LDS_MAIN))[threadIdx.x] = 0u;
    if ((threadIdx.x & 63) == 0) *(volatile int*)(shm + LDS_WTAB + 4 * hw_slot()) = (int)(threadIdx.x >> 6);
    __syncthreads();
    const int lo = kargs()->ph_lo, hi = kargs()->ph_hi;
    XcdBarrier bar; bar.bar = (unsigned*)(kargs()->ws + WS_CTL); bar.x = 0; bar.st = (volatile LAS unsigned*)(shm + LDS_MAIN);
    if (hi - lo > 1) bar = xcd_barrier_post((unsigned*)(kargs()->ws + WS_CTL), (volatile LAS unsigned*)(shm + LDS_MAIN));
#define IN(k) (lo <= (k) && (k) < hi)
#define SEAM(k) do { if (IN(k) && IN((k) + 1)) xcd_barrier(bar); } while (0)
    if (IN(0)) { ph_mod(kargs(), shm); ph_cvt(kargs(), 0, shm, 0); } SEAM(0);
    for (int l = 0; l < 2; ++l) {
        const int p0 = 1 + l * NPL;
        if (IN(p0 + 0)) { ph_norm1(kargs(), l, shm, l > 0); } SEAM(p0 + 0);
        if (IN(p0 + 1)) { ph_gemm_in(kargs(), l, shm); } SEAM(p0 + 1);
        if (IN(p0 + 2)) { lru::pass_a(kargs(), l, shm); } SEAM(p0 + 2);
        if (IN(p0 + 3)) { lru::pass_b(kargs(), l, shm); ph_prep(kargs(), l, shm); } SEAM(p0 + 3);
        if (IN(p0 + 4)) { ph_mix(kargs(), l, shm); } SEAM(p0 + 4);
        if (IN(p0 + 5)) { ssd::s2_scan(kargs()); gla::g2_scan(kargs()); } SEAM(p0 + 5);
        if (IN(p0 + 6)) { ph_ssd3(kargs(), l, shm); ph_gla3(kargs(), l, shm); } SEAM(p0 + 6);
        if (IN(p0 + 7)) { ph_gemm_gates(kargs(), l, shm); } SEAM(p0 + 7);
        if (IN(p0 + 8)) { ph_merge(kargs(), l, shm); if (l == 0) ph_cvt(kargs(), 0, shm, 1, 16); } SEAM(p0 + 8);
        if (IN(p0 + 9)) { ph_wout(kargs(), l, shm); if (l == 0) ph_cvt(kargs(), 1, shm, 2, 16); } SEAM(p0 + 9);
        if (IN(p0 + 10)) { ph_norm2(kargs(), l, shm); ph_cvt(kargs(), 1, shm, l == 0 ? 3 : 1); } SEAM(p0 + 10);
        if (IN(p0 + 11)) { ph_moe1(kargs(), l, shm); } SEAM(p0 + 11);
        if (IN(p0 + 12)) { ph_moe2(kargs(), l, shm); } SEAM(p0 + 12);
    }
    if (IN(1 + 2 * NPL)) { ph_final(kargs(), shm); }
#undef IN
#undef SEAM
}

extern "C" void kernel_launch(void* const* d_in, const int* in_sizes, int n_in, void* d_out, int out_size, void* d_ws, size_t ws_size, hipStream_t stream) {
    static int grid = 0;
    if (grid == 0) {
        if (n_in != 36 || out_size != NB * LAT * D || ws_size < WS_END) { fprintf(stderr, "kernel_launch: unexpected shapes (n_in %d out %d ws %zu need %zu)\n", n_in, out_size, ws_size, (size_t)WS_END); grid = -1; return; }
        int dev = 0, cus = 0;
        if (hipGetDevice(&dev) != hipSuccess || hipDeviceGetAttribute(&cus, hipDeviceAttributeMultiprocessorCount, dev) != hipSuccess) { grid = -1; return; }
        if (hipFuncSetAttribute((const void*)mk_fwd, hipFuncAttributeMaxDynamicSharedMemorySize, LDS_BYTES) != hipSuccess) { fprintf(stderr, "kernel_launch: hipFuncSetAttribute failed\n"); grid = -1; return; }
        int per_cu = 0;
        if (hipOccupancyMaxActiveBlocksPerMultiprocessor(&per_cu, (const void*)mk_fwd, NTHREADS, LDS_BYTES) != hipSuccess || per_cu < 1) { fprintf(stderr, "kernel_launch: occupancy query says %d\n", per_cu); }
        (void)hipGetLastError();
        grid = cus;
    }
    if (grid < 0) return;
    hipMemsetAsync((char*)d_ws + WS_CTL, 0, 16384, stream);
    Args a{};
    for (int i = 0; i < 36; ++i) a.in[i] = (const float*)d_in[i];
    a.out = (float*)d_out; a.ws = (unsigned char*)d_ws;
#if MK_ONE_LAUNCH
    a.ph_lo = 0; a.ph_hi = NPH;
    hipLaunchKernelGGL(mk_fwd, dim3(grid), dim3(NTHREADS), LDS_BYTES, stream, a);
#else
    for (int p = 0; p < NPH; ++p) { a.ph_lo = p; a.ph_hi = p + 1; hipLaunchKernelGGL(mk_fwd, dim3(grid), dim3(NTHREADS), LDS_BYTES, stream, a); }
#endif
}
```

```cpp
#include <hip/hip_runtime.h>
#include <stdint.h>
#include <stdio.h>

#ifndef MK_ONE_LAUNCH
#define MK_ONE_LAUNCH 1
#endif

typedef unsigned short bf16_t;
typedef short bf16x8 __attribute__((ext_vector_type(8)));
typedef short s16x4 __attribute__((ext_vector_type(4)));
typedef float f32x4 __attribute__((ext_vector_type(4)));
typedef float f32x16 __attribute__((ext_vector_type(16)));
typedef unsigned u32x4 __attribute__((ext_vector_type(4)));
typedef unsigned u32x2 __attribute__((ext_vector_type(2)));

constexpr int D = 1024, NB = 4, LAT = 4096, CTX = 256, SEQ = CTX + LAT, T = NB * SEQ;
constexpr int INW = 9776;
constexpr int NTHREADS = 512;
constexpr float EPS = 1e-6f;

constexpr size_t U = (size_t)T * 256 * 2;
constexpr size_t WS_Z = 0, WS_GR = 2 * U, WS_LG = 4 * U, WS_AQ = 6 * U, WS_GV = 8 * U, WS_LX = 10 * U, WS_AK = 12 * U, WS_AV = 13 * U,
                 WS_XBC = 14 * U, WS_GQ = 18 * U, WS_GK = 20 * U, WS_TMP = 22 * U, WS_H = 30 * U, WS_ACT_END = 34 * U;
constexpr size_t WS_GATES = 14 * U;
constexpr size_t WS_MOEA = 14 * U;
constexpr size_t WS_MOEO = 0;
constexpr size_t WS_XBCC = WS_TMP, WS_G = WS_TMP + 4 * U;
constexpr size_t WS_HF = WS_H, WS_HB = WS_H + 2 * U;
constexpr size_t WS_YS = WS_H, WS_OS = WS_H + 2 * U;
constexpr size_t WS_SST = WS_XBC;
constexpr size_t WS_WIN = WS_ACT_END;
constexpr int    NWIN = 9984;
constexpr size_t WS_WB = WS_WIN + (size_t)NWIN * 1024 * 2;
constexpr size_t WS_WO = WS_WB + (size_t)4 * 1024 * 512 * 2;
constexpr size_t WS_E13 = WS_WO + (size_t)1024 * 1024 * 2;
constexpr size_t WS_E2 = WS_E13 + (size_t)16 * 1024 * 1024 * 2;
constexpr size_t WS_GST0 = WS_TMP + 4 * U, WS_GST1 = WS_E13;
static_assert(WS_E2 + (size_t)16 * 1024 * 512 * 2 - WS_E13 >= 4 * U, "gla dir-1 states must fit the expert weight region");
constexpr size_t WS_SM = WS_E2 + (size_t)16 * 1024 * 512 * 2;
constexpr size_t WS_DTV = WS_SM + (size_t)T * 48 * 4;
constexpr size_t WS_XC = WS_DTV + (size_t)T * 16 * 4;
constexpr size_t WS_MOD = WS_XC + (size_t)NB * CTX * 1024 * 4;
constexpr int    MAXSLOT = 2 * T + 16 * 256;
constexpr size_t WS_TOKE = WS_MOD + (size_t)2 * 5 * 6144 * 4;
constexpr size_t WS_TOKP = WS_TOKE + (size_t)T * 2 * 4;
constexpr size_t WS_TOKW = WS_TOKP + (size_t)T * 2 * 4;
constexpr size_t WS_LIST = WS_TOKW + (size_t)T * 2 * 4;
constexpr size_t WS_CNT = WS_LIST + (size_t)16 * T * 4;
constexpr size_t WS_SSQ = WS_CNT + 256;
constexpr size_t WS_CD = WS_SSQ + (size_t)T * 2 * 4;
constexpr size_t WS_GTOT = WS_CD + (size_t)NB * 2 * 34 * 8 * 4 + 128;
constexpr size_t WS_LSUM = WS_GTOT + (size_t)NB * 2 * 68 * 4 * 128 * 4;
constexpr size_t WS_G2T = WS_LSUM + (size_t)NB * 2 * 34 * 512 * 2 * 4;
constexpr size_t WS_CTL = WS_G2T + 2 * 512 * 16 * 2;
constexpr size_t WS_GE = WS_CTL + 16384;
constexpr size_t WS_END = WS_GE + 3 * U;

#define XB_TMO      128
#define XB_XCNT(j)  (256  + 64 * (j))
#define XB_XSUB(j)  (1280 + 64 * (j))
#define XB_XGEN(j)  (2304 + 64 * (j))
#define XB_TOP      3328
#define XB_TOPGEN   3392
#define XCD_BAR_WORDS 3456
#define XB_SPIN_CAP (1u << 24)
#define LAS __attribute__((address_space(3)))

__device__ __forceinline__ unsigned xb_ld(unsigned* p)              { return __hip_atomic_load(p, __ATOMIC_RELAXED, __HIP_MEMORY_SCOPE_AGENT); }
__device__ __forceinline__ unsigned xb_add(unsigned* p, unsigned v) { return __hip_atomic_fetch_add(p, v, __ATOMIC_RELAXED, __HIP_MEMORY_SCOPE_AGENT); }
__device__ __forceinline__ unsigned xb_xcc_id() { return (unsigned)__builtin_amdgcn_s_getreg((3 << 11) | 20) & 0xFu; }
#define XB_SPIN(cond, bar) do { unsigned _sp = 0; while (cond) { __builtin_amdgcn_s_sleep(1); \
    if ((++_sp & 255u) == 0u) { if (xb_ld(&(bar)[XB_TMO])) break; if (_sp > XB_SPIN_CAP) { atomicAdd(&(bar)[XB_TMO], 1u); break; } } } } while (0)

struct XcdBarrier { unsigned* bar; unsigned x; volatile LAS unsigned* st; };
__device__ __forceinline__ bool xb_tid0();

__device__ __forceinline__ XcdBarrier xcd_barrier_post(unsigned* bar, volatile LAS unsigned* st) {
    XcdBarrier b; b.bar = bar; b.x = xb_xcc_id(); b.st = st;
    if (xb_tid0()) (void)xb_add(&bar[XB_XCNT(b.x)], 1u);
    return b;
}
__device__ __forceinline__ void xcd_barrier_complete(unsigned* bar, unsigned x, unsigned& nloc, unsigned& nx) {
    const unsigned G = gridDim.x * gridDim.y * gridDim.z;
    unsigned sum, cnt, mine, sp = 0u;
    for (;;) {
        sum = 0u; cnt = 0u; mine = 0u;
#pragma unroll
        for (unsigned j = 0; j < 16; ++j) { const unsigned c = xb_ld(&bar[XB_XCNT(j)]); sum += c; cnt += (c > 0u) ? 1u : 0u; mine = (j == x) ? c : mine; }
        if (sum == G) break;
        __builtin_amdgcn_s_sleep(1);
        if ((++sp & 255u) == 0u) { if (xb_ld(&bar[XB_TMO])) break; if (sp > XB_SPIN_CAP) { atomicAdd(&bar[XB_TMO], 1u); break; } }
    }
    nloc = mine > 0u ? mine : 1u; nx = cnt > 0u ? cnt : 1u;
}
__device__ __forceinline__ void xcd_barrier(const XcdBarrier& b) {
    asm volatile("s_waitcnt vmcnt(0)" ::: "memory");
    __syncthreads();
    if (xb_tid0()) {
        unsigned* bar = b.bar;
        __builtin_amdgcn_s_waitcnt(0);
        unsigned nloc = b.st[0], nx = b.st[1];
        if (nloc == 0u) { xcd_barrier_complete(bar, b.x, nloc, nx); b.st[0] = nloc; b.st[1] = nx; }
        const unsigned old = xb_add(&bar[XB_XSUB(b.x)], 1u);
        const unsigned gen = old / nloc;
        if (old + 1u == (gen + 1u) * nloc) {
            __builtin_amdgcn_fence(__ATOMIC_RELEASE, "agent");
            asm volatile("s_waitcnt vmcnt(0)" ::: "memory");
            (void)xb_add(&bar[XB_TOP], 1u);
        }
        __builtin_amdgcn_fence(__ATOMIC_ACQUIRE, "agent");
        XB_SPIN(xb_ld(&bar[XB_TOP]) < (gen + 1u) * nx, bar);
        asm volatile("s_waitcnt vmcnt(0)" ::: "memory");
    }
    __syncthreads();
}

constexpr int LDS_MAIN = 131072;
struct Args { const float* in[36]; float* out; unsigned char* ws; int ph_lo, ph_hi; };
typedef const Args __attribute__((address_space(4)))* KArgs;
__device__ __forceinline__ KArgs kargs() { KArgs p = (KArgs)__builtin_amdgcn_kernarg_segment_ptr(); asm volatile("" : "+s"(p)); return p; }

constexpr int LDS_WTAB = LDS_MAIN + 12032;
__device__ __forceinline__ unsigned hw_slot() { return (unsigned)__builtin_amdgcn_s_getreg((5 << 11) | 4) & 63u; }
__device__ __forceinline__ int ltid() {
    extern __shared__ __attribute__((aligned(16))) char shm_[];
    const int w = *(volatile int*)(shm_ + LDS_WTAB + 4 * hw_slot());
    int lane; asm volatile("v_mbcnt_lo_u32_b32 %0, -1, 0\n\tv_mbcnt_hi_u32_b32 %0, -1, %0" : "=v"(lane));
    return (__builtin_amdgcn_readfirstlane(w) << 6) | lane;
}
__device__ __forceinline__ bool xb_tid0() { return ltid() == 0; }
__device__ __forceinline__ float bf2f(bf16_t v) { return __uint_as_float(((unsigned)v) << 16); }
__device__ __forceinline__ bf16_t f2bf(float f) { unsigned u = __float_as_uint(f); u += 0x7fffu + ((u >> 16) & 1u); return (bf16_t)(u >> 16); }
typedef float f32x2_t __attribute__((ext_vector_type(2)));
typedef __bf16 bf16x2_t __attribute__((ext_vector_type(2)));
__device__ __forceinline__ unsigned cvtpk(float lo, float hi) { const f32x2_t v = {lo, hi}; const bf16x2_t b = __builtin_convertvector(v, bf16x2_t); return __builtin_bit_cast(unsigned, b); }
__device__ __forceinline__ unsigned cvtpk_asm(float lo, float hi) { unsigned r; asm volatile("v_cvt_pk_bf16_f32 %0, %1, %2" : "=v"(r) : "v"(lo), "v"(hi)); return r; }
__device__ __forceinline__ u32x4 pair16(u32x2 A, u32x2 B) {
    const auto rx = __builtin_amdgcn_permlane32_swap(A[0], B[0], false, false); const auto ry = __builtin_amdgcn_permlane32_swap(A[1], B[1], false, false);
    return (u32x4){rx[0], ry[0], rx[1], ry[1]}; }
__device__ __forceinline__ float lo_bf(unsigned w) { return __uint_as_float(w << 16); }
__device__ __forceinline__ float hi_bf(unsigned w) { return __uint_as_float(w & 0xffff0000u); }
__device__ __forceinline__ float sigmoidf_(float x) { return __builtin_amdgcn_rcpf(1.f + __expf(-x)); }
__device__ __forceinline__ float siluf_(float x) { return x * __builtin_amdgcn_rcpf(1.f + __expf(-x)); }
__device__ __forceinline__ float softplusf_(float x) { return x > 20.f ? x : log1pf(__expf(x)); }
__device__ __forceinline__ float softplus_rel(float x) { if (x > 15.f) return x; const float e = __expf(x); return e < 0.06f ? e * (1.f - e * (0.5f - e * (0.33333334f - e * (0.25f - e * 0.2f)))) : __logf(1.f + e); }
__device__ __forceinline__ float softplus_fast(float x) { return x > 15.f ? x : __logf(1.f + __expf(x)); }
__device__ __forceinline__ float tanh_fast(float x) { const float e = __expf(2.f * x); return 1.f - 2.f * __builtin_amdgcn_rcpf(e + 1.f); }
__device__ __forceinline__ float gelu_tanh(float x) { const float u = 0.7978845608028654f * (x + 0.044715f * x * x * x); return 0.5f * x * (1.f + tanh_fast(u)); }
__device__ __forceinline__ float wave_sum(float v) {
#pragma unroll
    for (int o = 32; o >= 1; o >>= 1) v += __shfl_xor(v, o, 64);
    return v;
}
__device__ __forceinline__ float* xrow(KArgs a, int row) {
    const int b = row / SEQ, pos = row - b * SEQ;
    return pos < CTX ? (float*)(a->ws + WS_XC) + (size_t)(b * CTX + pos) * D : a->out + (size_t)(b * LAT + pos - CTX) * D;
}
__device__ __forceinline__ const float* xrow_in(KArgs a, int row) {
    const int b = row / SEQ, pos = row - b * SEQ;
    return pos < CTX ? a->in[2] + (size_t)(b * CTX + pos) * D : a->in[0] + (size_t)(b * LAT + pos - CTX) * D;
}
__device__ __forceinline__ const float* modp(KArgs a, int l, int row, int chunk) {
    const int b = row / SEQ, pos = row - b * SEQ; const int j = pos < CTX ? 4 : b;
    return (const float*)(a->ws + WS_MOD) + ((size_t)(l * 5 + j) * 6 + chunk) * 1024;
}

constexpr int BM = 256, BK = 64, HALF = 128, HT = HALF * BK;
__device__ __forceinline__ int lds_byte(int r, int c) { int st = (r >> 4) * 2 + (c >> 5), rr = r & 15, cc = c & 31, ob = rr * 64 + cc * 2; return st * 1024 + (ob ^ (((ob >> 9) & 1) << 5)); }
__device__ __forceinline__ void stage_rc(int b, int& R, int& C) { int st = b / 1024, sb = b % 1024, swz = sb ^ (((sb >> 9) & 1) << 5); R = (st >> 1) * 16 + swz / 64; C = (st & 1) * 32 + (swz % 64) / 2; }

struct AMapId { int base; int K; __device__ __forceinline__ unsigned voff(int) const { return (unsigned)base * 2u; } __device__ __forceinline__ size_t soff(int q) const { return (size_t)q * 64 * K * 2; } };
struct AMapG  { int o[4]; __device__ __forceinline__ unsigned voff(int q) const { return (unsigned)o[q] * 2u; } __device__ __forceinline__ size_t soff(int) const { return 0; } };
__device__ __forceinline__ void glds16(const void* sbase, unsigned voff, unsigned lds_dst) {
    unsigned keep;
    asm volatile("s_mov_b32 %0, m0\n\ts_mov_b32 m0, %3\n\ts_nop 0\n\tglobal_load_lds_dwordx4 %1, %2\n\ts_mov_b32 m0, %0" : "=&s"(keep) : "v"(voff), "s"(sbase), "s"(lds_dst) : "memory");
}

template <class AM, bool ZERO = true>
__device__ __forceinline__ void gemm_tile(const bf16_t* __restrict__ A, const bf16_t* __restrict__ Bt, const int K, const AM am, const int bbase  ,
                                          f32x4 (&acc)[2][2][4][2], char* shmc) {
    bf16_t* shm = (bf16_t*)shmc;
#define SA(b,h) (shm+((b)*2+(h))*HT)
#define SB(b,h) (shm+(4+(b)*2+(h))*HT)
#define STAGE_A(P,h,kt) do{ for(int _i=0;_i<2;++_i){ \
      glds16((const char*)(A+(kt)*BK)+am.soff((h)*2+_i), am.voff((h)*2+_i), lbase+(unsigned)((const char*)(P)-shmc)+wvu*1024u+_i*8192u);} }while(0)
#define STAGE_B(P,h,kt) do{ for(int _i=0;_i<2;++_i){ \
      glds16((const char*)(Bt+((h)*2+_i)*64*K+(kt)*BK), bboff, lbase+(unsigned)((const char*)(P)-shmc)+wvu*1024u+_i*8192u);} }while(0)
#define LDA(dst,b,h) for(int m=0;m<4;++m)for(int k=0;k<2;++k) \
    dst[m][k]=*reinterpret_cast<const bf16x8*>(shmc+laA+(((b)*2+(h))*HT*2+m*2048+k*1024))
#define LDB(dst,b,h) for(int n=0;n<2;++n)for(int k=0;k<2;++k) \
    dst[n][k]=*reinterpret_cast<const bf16x8*>(shmc+laB+(((b)*2+(h))*HT*2+n*2048+k*1024))
#define MMA(ai,bj,At,Bx) do{__builtin_amdgcn_s_setprio(1); \
    for(int m=0;m<4;++m)for(int n=0;n<2;++n)for(int k=0;k<2;++k) \
      acc[ai][bj][m][n]=__builtin_amdgcn_mfma_f32_16x16x32_bf16(Bx[n][k],At[m][k],acc[ai][bj][m][n],0,0,0); \
    __builtin_amdgcn_s_setprio(0);}while(0)
#define WAIT_V(n) asm volatile("s_waitcnt vmcnt(" #n ")":::"memory")
#define WAIT_L(n) asm volatile("s_waitcnt lgkmcnt(" #n ")":::"memory")
#define BAR __builtin_amdgcn_s_barrier()
#define SCHED __builtin_amdgcn_sched_barrier(0)
    int tz = ltid();
    const unsigned bboff = (unsigned)bbase * 2u;
    const unsigned lbase = (unsigned)(uintptr_t)shmc;
    const int wid = tz >> 6, lane = tz & 63, wr = wid >> 2, wc = wid & 3, fr = lane & 15, fq = lane >> 4;
    const unsigned wvu = (unsigned)__builtin_amdgcn_readfirstlane(wid);
    const int laA = lds_byte(wr * 64 + fr, fq * 8), laB = 4 * HT * 2 + lds_byte(wc * 32 + fr, fq * 8);
    if (ZERO) {
#pragma unroll
    for (int ai = 0; ai < 2; ++ai)
#pragma unroll
        for (int bj = 0; bj < 2; ++bj)
#pragma unroll
            for (int m = 0; m < 4; ++m)
#pragma unroll
                for (int n = 0; n < 2; ++n) acc[ai][bj][m][n] = (f32x4){0.f, 0.f, 0.f, 0.f};
    }
    bf16x8 At[4][2], B0[2][2], B1[2][2];
    const int nt = K / BK;
    STAGE_B(SB(0,0),0,0); STAGE_A(SA(0,0),0,0);
    STAGE_B(SB(0,1),1,0); STAGE_A(SA(0,1),1,0);
    if (wr == 1) BAR;
    WAIT_V(4); BAR;
    STAGE_B(SB(1,0),0,1); STAGE_A(SA(1,0),0,1); STAGE_B(SB(1,1),1,1);
    WAIT_V(6); BAR;
    for (int t = 0; t < nt - 2; t += 2) {
        LDB(B0,0,0); SCHED; LDA(At,0,0); STAGE_A(SA(1,1),1,t+1);
        WAIT_L(8); BAR; WAIT_L(0); MMA(0,0,At,B0); BAR; SCHED;
        LDB(B1,0,1); STAGE_B(SB(0,0),0,t+2);
        BAR; WAIT_L(0); MMA(0,1,At,B1); BAR;
        LDA(At,0,1); STAGE_A(SA(0,0),0,t+2);
        BAR; WAIT_L(0); MMA(1,0,At,B0); BAR; SCHED;
        STAGE_B(SB(0,1),1,t+2);
        WAIT_V(6); BAR; MMA(1,1,At,B1); BAR;
        LDB(B0,1,0); SCHED; LDA(At,1,0); STAGE_A(SA(0,1),1,t+2);
        WAIT_L(8); BAR; WAIT_L(0); MMA(0,0,At,B0); BAR; SCHED;
        LDB(B1,1,1); STAGE_B(SB(1,0),0,t+3);
        BAR; WAIT_L(0); MMA(0,1,At,B1); BAR;
        LDA(At,1,1); STAGE_A(SA(1,0),0,t+3);
        BAR; WAIT_L(0); MMA(1,0,At,B0); BAR; SCHED;
        STAGE_B(SB(1,1),1,t+3);
        WAIT_V(6); BAR; MMA(1,1,At,B1); BAR;
    }
    { LDB(B0,0,0); WAIT_V(0); LDA(At,0,0); STAGE_A(SA(1,1),1,nt-1);
      BAR; WAIT_L(0); MMA(0,0,At,B0); BAR;
      LDB(B1,0,1); BAR; WAIT_L(0); MMA(0,1,At,B1); BAR;
      LDA(At,0,1); WAIT_V(4); BAR; WAIT_L(0); MMA(1,0,At,B0); MMA(1,1,At,B1); BAR; }
    { LDB(B0,1,0); LDA(At,1,0); WAIT_V(2); BAR; WAIT_L(0); MMA(0,0,At,B0); BAR;
      LDB(B1,1,1); WAIT_V(0); BAR; WAIT_L(0); MMA(0,1,At,B1); BAR;
      LDA(At,1,1); BAR; WAIT_L(0); MMA(1,0,At,B0); MMA(1,1,At,B1); BAR; }
    if (wr == 0) BAR;
    asm volatile("" ::: "memory");
#undef SA
#undef SB
#undef STAGE_A
#undef STAGE_B
#undef LDA
#undef LDB
#undef MMA
}
template <class AM, class DescF, class EpiF>
__device__ __forceinline__ void gemm_stream(const int K, const int ntl, DescF desc, EpiF epi, char* shmc) {
    if (ntl <= 0) return;
    bf16_t* shm = (bf16_t*)shmc;
#define SA(b,h) (shm+((b)*2+(h))*HT)
#define SB(b,h) (shm+(4+(b)*2+(h))*HT)
#ifndef WAIT_V
#define WAIT_V(n) asm volatile("s_waitcnt vmcnt(" #n ")":::"memory")
#define WAIT_L(n) asm volatile("s_waitcnt lgkmcnt(" #n ")":::"memory")
#define BAR __builtin_amdgcn_s_barrier()
#define SCHED __builtin_amdgcn_sched_barrier(0)
#endif
#define XSTAGE_A(P,h,DA,DM,kt) do{ for(int _i=0;_i<2;++_i){ \
      glds16((const char*)((DA)+(kt)*BK)+(DM).soff((h)*2+_i), (DM).voff((h)*2+_i), lbase+(unsigned)((const char*)(P)-shmc)+wvu*1024u+_i*8192u);} }while(0)
#define XSTAGE_B(P,h,DB,DO,kt) do{ for(int _i=0;_i<2;++_i){ \
      glds16((const char*)((DB)+((h)*2+_i)*64*K+(kt)*BK), (DO), lbase+(unsigned)((const char*)(P)-shmc)+wvu*1024u+_i*8192u);} }while(0)
#define LDA(dst,b,h) for(int m=0;m<4;++m)for(int k=0;k<2;++k) \
    dst[m][k]=*reinterpret_cast<const bf16x8*>(shmc+laA+(((b)*2+(h))*HT*2+m*2048+k*1024))
#define LDB(dst,b,h) for(int n=0;n<2;++n)for(int k=0;k<2;++k) \
    dst[n][k]=*reinterpret_cast<const bf16x8*>(shmc+laB+(((b)*2+(h))*HT*2+n*2048+k*1024))
#define MMA(ai,bj,At,Bx) do{__builtin_amdgcn_s_setprio(1); \
    for(int m=0;m<4;++m)for(int n=0;n<2;++n)for(int k=0;k<2;++k) \
      acc[ai][bj][m][n]=__builtin_amdgcn_mfma_f32_16x16x32_bf16(Bx[n][k],At[m][k],acc[ai][bj][m][n],0,0,0); \
    __builtin_amdgcn_s_setprio(0);}while(0)
    const int tz = ltid();
    const unsigned lbase = (unsigned)(uintptr_t)shmc;
    const int wid = tz >> 6, lane = tz & 63, wr = wid >> 2, wc = wid & 3, fr = lane & 15, fq = lane >> 4;
    const unsigned wvu = (unsigned)__builtin_amdgcn_readfirstlane(wid);
    const int laA = lds_byte(wr * 64 + fr, fq * 8), laB = 4 * HT * 2 + lds_byte(wc * 32 + fr, fq * 8);
    const int nt = K / BK;
    const bf16_t* cA; const bf16_t* cB; AM cM; unsigned cO;
    const bf16_t* nA; const bf16_t* nB; AM nM; unsigned nO;
    desc(0, cA, cB, cM, cO);
    XSTAGE_B(SB(0,0),0,cB,cO,0); XSTAGE_A(SA(0,0),0,cA,cM,0);
    XSTAGE_B(SB(0,1),1,cB,cO,0); XSTAGE_A(SA(0,1),1,cA,cM,0);
    if (wr == 1) BAR;
    WAIT_V(4); BAR;
    XSTAGE_B(SB(1,0),0,cB,cO,1); XSTAGE_A(SA(1,0),0,cA,cM,1); XSTAGE_B(SB(1,1),1,cB,cO,1);
    WAIT_V(6); BAR;
    for (int kt = 0; kt < ntl; ++kt) {
        if (kt + 1 < ntl) desc(kt + 1, nA, nB, nM, nO); else { nA = cA; nB = cB; nM = cM; nO = cO; }
        f32x4 acc[2][2][4][2];
#pragma unroll
        for (int ai = 0; ai < 2; ++ai)
#pragma unroll
            for (int bj = 0; bj < 2; ++bj)
#pragma unroll
                for (int m = 0; m < 4; ++m)
#pragma unroll
                    for (int n = 0; n < 2; ++n) acc[ai][bj][m][n] = (f32x4){0.f, 0.f, 0.f, 0.f};
        bf16x8 At[4][2], B0[2][2], B1[2][2];
        for (int t = 0; t < nt; t += 2) {
            const bool last = t + 2 >= nt;
            const bf16_t* sA = last ? nA : cA; const bf16_t* sB = last ? nB : cB; const unsigned sO = last ? nO : cO; const int k2 = last ? 0 : t + 2, k3 = last ? 1 : t + 3;
            AM sM = cM; if (last) sM = nM;
            LDB(B0,0,0); SCHED; LDA(At,0,0); XSTAGE_A(SA(1,1),1,cA,cM,t+1);
            WAIT_L(8); BAR; WAIT_L(0); MMA(0,0,At,B0); BAR; SCHED;
            LDB(B1,0,1); XSTAGE_B(SB(0,0),0,sB,sO,k2);
            BAR; WAIT_L(0); MMA(0,1,At,B1); BAR;
            LDA(At,0,1); XSTAGE_A(SA(0,0),0,sA,sM,k2);
            BAR; WAIT_L(0); MMA(1,0,At,B0); BAR; SCHED;
            XSTAGE_B(SB(0,1),1,sB,sO,k2);
            WAIT_V(6); BAR; MMA(1,1,At,B1); BAR;
            LDB(B0,1,0); SCHED; LDA(At,1,0); XSTAGE_A(SA(0,1),1,sA,sM,k2);
            WAIT_L(8); BAR; WAIT_L(0); MMA(0,0,At,B0); BAR; SCHED;
            LDB(B1,1,1); XSTAGE_B(SB(1,0),0,sB,sO,k3);
            BAR; WAIT_L(0); MMA(0,1,At,B1); BAR;
            LDA(At,1,1); XSTAGE_A(SA(1,0),0,sA,sM,k3);
            BAR; WAIT_L(0); MMA(1,0,At,B0); BAR; SCHED;
            XSTAGE_B(SB(1,1),1,sB,sO,k3);
            WAIT_V(6); BAR; MMA(1,1,At,B1); BAR;
        }
        if (kt + 1 == ntl) { WAIT_V(0); if (wr == 0) BAR; }
        asm volatile("" ::: "memory");
        epi(kt, acc);
        cA = nA; cB = nB; cM = nM; cO = nO;
    }
#undef XSTAGE_A
#undef XSTAGE_B
#undef LDA
#undef LDB
#undef MMA
#undef SA
#undef SB
}
#define EPI_LANES int tz_ = ltid(); const int wid = tz_ >> 6, lane = tz_ & 63, wr = wid >> 2, wc = wid & 3, fr = lane & 15, fq = lane >> 4
__device__ __forceinline__ void stage_coords(int& R0, int& C0) { stage_rc(ltid() * 16, R0, C0); }
__device__ __forceinline__ int xcd_unit(int k, int nu) { const int G = gridDim.x, bx = blockIdx.x;
    if ((G & 7) == 0 && (k + 1) * G <= nu) return k * G + (bx & 7) * (G >> 3) + (bx >> 3);
    return k * G + bx; }
__device__ __forceinline__ int bperm(int r) { return (r & ~31) | (((r >> 2) & 3) << 3) | (((r >> 4) & 1) << 2) | (r & 3); }

__device__ __forceinline__ int n_row_tiles(int l) { return l == 0 ? 68 : 64; }
__device__ __forceinline__ int row_tile_base(int l, int i) { return l == 0 ? i * 256 : ((i >> 4) * 17 + 1 + (i & 15)) * 256; }

__device__ __forceinline__ void ph_mod(KArgs a, char* shm) {
    float* s = (float*)shm;
    float* red = s + 5 * 1024;
    const int tid = ltid();
    if (blockIdx.x == 0 && tid < 64) ((int*)(a->ws + WS_CNT))[tid] = 0;
    for (int i = tid; i < 5 * 1024; i += NTHREADS) { const int j = i >> 10, k = i & 1023; const float c = j < 4 ? a->in[1][j * 1024 + k] : a->in[3][k]; s[i] = siluf_(c); }
    __syncthreads();
    const int cq = tid & 15, ks = tid >> 4;
    for (int u = blockIdx.x; u < 192; u += gridDim.x) {
        const int l = u / 96, c0 = (u % 96) * 64;
        const float* w = a->in[4] + (size_t)l * 1024 * 6144 + c0 + cq * 4;
        f32x4 acc[5];
#pragma unroll
        for (int j = 0; j < 5; ++j) acc[j] = (f32x4){0.f, 0.f, 0.f, 0.f};
#pragma unroll 16
        for (int k = ks * 32; k < ks * 32 + 32; ++k) { const f32x4 wv = *(const f32x4*)(w + (size_t)k * 6144);
#pragma unroll
            for (int j = 0; j < 5; ++j) acc[j] += s[j * 1024 + k] * wv; }
#pragma unroll
        for (int j = 0; j < 5; ++j) *(f32x4*)(red + (ks * 5 + j) * 64 + cq * 4) = acc[j];
        __syncthreads();
        if (tid < 320) { const int j = tid >> 6, cg = tid & 63; float v = a->in[5][l * 6144 + c0 + cg];
            for (int q = 0; q < 32; ++q) v += red[(q * 5 + j) * 64 + cg];
            ((float*)(a->ws + WS_MOD))[(size_t)(l * 5 + j) * 6144 + c0 + cg] = v; }
        __syncthreads();
    }
}

__device__ __forceinline__ int win_srccol(int r) {
    if (r < 512) return r;
    if (r < 1024) return 3120 + (r - 512);
    if (r < 1536) return 4144 + (r - 1024);
    if (r < 2048) return 4656 + (r - 1536);
    if (r < 2560) return 2576 + (r - 2048);
    if (r < 3072) return 3632 + (r - 2560);
    if (r < 3328) return 5168 + (r - 3072);
    if (r < 3584) return 5424 + (r - 3328);
    if (r < 4608) return 512 + (r - 3584);
    if (r < 5120) return 1552 + (r - 4608);
    if (r < 5632) return 2064 + (r - 5120);
    if (r < 5648) return 1536 + (r - 5632);
    if (r < 5680) return 3088 + (r - 5648);
    if (r < 5888) return -1;
    return 5680 + (r - 5888);
}
__device__ __forceinline__ void ph_cvt(KArgs a, int l, char* shm, int part, int fb = 0) {
    if ((int)blockIdx.x < fb) return;
    float* t = (float*)shm;
    const int tid = ltid();
    constexpr int N_WIN = (NWIN / 64) * 16, N_WB = 4 * 16 * 8, N_WO = 16 * 16, N_E13 = 16 * 16 * 16, N_E2 = 16 * 16 * 8;
    constexpr int NTOT = N_WIN + N_WB + N_WO + N_E13 + N_E2;
    const int bxe = blockIdx.x - fb, Ge = gridDim.x - fb;
    if (part == 0 || part == 2) { bf16_t* G2T = (bf16_t*)(a->ws + WS_G2T); for (int i = bxe * NTHREADS + tid; i < 2 * 512 * 16; i += Ge * NTHREADS) { const int d = i >> 13, k = (i >> 4) & 511, r = i & 15; G2T[i] = f2bf(a->in[15][((l * 2 + d) * 16 + r) * 512 + k]); } }
    constexpr int U1 = N_WIN + N_WB, U2 = U1 + N_WO, U3 = U2 + N_E13;
    const int ulo = part == 1 || part == 4 ? U2 : (part == 3 ? U1 : (part == 5 ? U3 : 0)), uhi = part == 1 || part == 5 ? NTOT : (part == 2 ? U1 : (part == 4 ? U3 : U2));
    for (int u = ulo + bxe; u < uhi; u += Ge) {
        const float* src; int ld, kind, n0, k0, K; bf16_t* dst; const float* src2 = nullptr;
        int v = u;
        if (v < N_WIN) { src = a->in[8] + (size_t)l * 1024 * INW; ld = INW; kind = 1; n0 = (v / 16) * 64; k0 = (v % 16) * 64; K = 1024; dst = (bf16_t*)(a->ws + WS_WIN); }
        else if ((v -= N_WIN) < N_WB) { const int n = v / 128, r = v % 128; src = a->in[27] + (size_t)(l * 4 + n) * 512 * 1024; ld = 1024; kind = 0; n0 = (r / 8) * 64; k0 = (r % 8) * 64; K = 512;
                                        dst = (bf16_t*)(a->ws + WS_WB) + (size_t)n * 1024 * 512; }
        else if ((v -= N_WB) < N_WO) { src = a->in[28] + (size_t)l * 1024 * 1024; ld = 1024; kind = 0; n0 = (v / 16) * 64; k0 = (v % 16) * 64; K = 1024; dst = (bf16_t*)(a->ws + WS_WO); }
        else if ((v -= N_WO) < N_E13) { const int e = v / 256, r = v % 256; src = a->in[33] + (size_t)(l * 16 + e) * 1024 * 512; src2 = a->in[34] + (size_t)(l * 16 + e) * 1024 * 512;
                                        ld = 512; kind = 2; n0 = (r / 16) * 64; k0 = (r % 16) * 64; K = 1024; dst = (bf16_t*)(a->ws + WS_E13) + (size_t)e * 1024 * 1024; }
        else { v -= N_E13; const int e = v / 128, r = v % 128; src = a->in[35] + (size_t)(l * 16 + e) * 512 * 1024; ld = 1024; kind = 0; n0 = (r / 8) * 64; k0 = (r % 8) * 64; K = 512;
               dst = (bf16_t*)(a->ws + WS_E2) + (size_t)e * 1024 * 512; }
        {   const int tx4 = tid & 15, ty = tid >> 4; const int n = n0 + tx4 * 4; int sc; const float* sp = src;
            if (kind == 0) sc = n; else if (kind == 1) sc = win_srccol(n); else { const int p = n & 255, w3 = (p >> 4) & 1; sc = (n >> 8) * 128 + ((p >> 5) & 3) * 32 + ((p >> 2) & 3) * 8 + (p >> 7) * 4; if (w3) sp = src2; }
#pragma unroll
            for (int i = 0; i < 2; ++i) { const int k = ty + 32 * i; const f32x4 v = sc >= 0 ? *(const f32x4*)(sp + (size_t)(k0 + k) * ld + sc) : (f32x4){0.f, 0.f, 0.f, 0.f};
                float* tp = t + k * 65 + tx4 * 4; tp[0] = v[0]; tp[1] = v[1]; tp[2] = v[2]; tp[3] = v[3]; }
        }
        __syncthreads();
        {   const int n = tid >> 3, ks = tid & 7;
            float v8[8];
#pragma unroll
            for (int j = 0; j < 8; ++j) v8[j] = t[(ks * 8 + j) * 65 + n];
            u32x4 w = {cvtpk(v8[0], v8[1]), cvtpk(v8[2], v8[3]), cvtpk(v8[4], v8[5]), cvtpk(v8[6], v8[7])};
            *(u32x4*)(dst + (size_t)(n0 + n) * K + k0 + ks * 8) = w;
        }
        __syncthreads();
    }
}

__device__ __forceinline__ void moe_offsets(KArgs a, int l, int* off);
__device__ __forceinline__ void moe_row(KArgs a, int l, int row, int lane, const int* off, f32x4 (&o)[4]);
__device__ __forceinline__ void ph_norm1(KArgs a, int l, char* shm, bool fuse) {
    int* off = (int*)(shm + LDS_MAIN + 16); if (fuse) moe_offsets(a, l - 1, off);
    const int tid = ltid(); const int lane = tid & 63, wv = tid >> 6;
    const float* g = a->in[6] + l * 1024;
    bf16_t* H = (bf16_t*)(a->ws + WS_H);
    const int* TE = (const int*)(a->ws + WS_TOKE); const int* TP = (const int*)(a->ws + WS_TOKP); const float* TW = (const float*)(a->ws + WS_TOKW);
    const bf16_t* MO = (const bf16_t*)(a->ws + WS_MOEO);
    const int step = gridDim.x * 8;
    int row = blockIdx.x * 8 + wv;
    f32x4 pv[4]; int pe0 = 0, pe1 = 0, pp0 = 0, pp1 = 0; float pw0 = 0.f, pw1 = 0.f;
    {   const int r = row < T ? row : 0; const float* x = l == 0 ? xrow_in(a, r) : (const float*)xrow(a, r);
#pragma unroll
        for (int i = 0; i < 4; ++i) pv[i] = *(const f32x4*)(x + i * 256 + lane * 4);
        if (fuse) { pe0 = TE[r * 2]; pe1 = TE[r * 2 + 1]; pp0 = TP[r * 2]; pp1 = TP[r * 2 + 1]; pw0 = TW[r * 2]; pw1 = TW[r * 2 + 1]; } }
    for (; row < T; row += step) {
        f32x4 v[4];
#pragma unroll
        for (int i = 0; i < 4; ++i) v[i] = pv[i];
        const int e0 = pe0, e1 = pe1, p0 = pp0, p1 = pp1; const float w0 = pw0, w1 = pw1;
        const float* sh = modp(a, l, row, 0); const float* sc = modp(a, l, row, 1);
        f32x4 gg[4], s1[4], s0[4];
#pragma unroll
        for (int i = 0; i < 4; ++i) { const int c = i * 256 + lane * 4; gg[i] = *(const f32x4*)(g + c); s1[i] = *(const f32x4*)(sc + c); s0[i] = *(const f32x4*)(sh + c); }
        u32x2 mp[4], mq[4]; f32x4 g2v[4];
#pragma unroll
        for (int i = 0; i < 4; ++i) { mp[i] = (u32x2){0u, 0u}; mq[i] = (u32x2){0u, 0u}; g2v[i] = (f32x4){0.f, 0.f, 0.f, 0.f}; }
        if (fuse) { const int sa = off[e0] + p0, sb = off[e1] + p1; const float* g2 = modp(a, l - 1, row, 5);
#pragma unroll
            for (int i = 0; i < 4; ++i) { const int c = i * 256 + lane * 4; mp[i] = *(const u32x2*)(MO + (size_t)sa * 1024 + c); mq[i] = *(const u32x2*)(MO + (size_t)sb * 1024 + c); g2v[i] = *(const f32x4*)(g2 + c); } }
        {   const int r = row + step < T ? row + step : row; const float* x = l == 0 ? xrow_in(a, r) : (const float*)xrow(a, r);
#pragma unroll
            for (int i = 0; i < 4; ++i) pv[i] = *(const f32x4*)(x + i * 256 + lane * 4);
            if (fuse) { pe0 = TE[r * 2]; pe1 = TE[r * 2 + 1]; pp0 = TP[r * 2]; pp1 = TP[r * 2 + 1]; pw0 = TW[r * 2]; pw1 = TW[r * 2 + 1]; } }
        __builtin_amdgcn_sched_barrier(0);
        if (fuse) { float* xw = xrow(a, row);
#pragma unroll
            for (int i = 0; i < 4; ++i) { const u32x2 p = mp[i], q = mq[i]; const f32x4 gq = g2v[i];
                v[i] += (f32x4){gq[0] * (w0 * lo_bf(p[0]) + w1 * lo_bf(q[0])), gq[1] * (w0 * hi_bf(p[0]) + w1 * hi_bf(q[0])), gq[2] * (w0 * lo_bf(p[1]) + w1 * lo_bf(q[1])), gq[3] * (w0 * hi_bf(p[1]) + w1 * hi_bf(q[1]))};
                *(f32x4*)(xw + i * 256 + lane * 4) = v[i]; } }
        float ss = 0.f;
#pragma unroll
        for (int i = 0; i < 4; ++i) ss += v[i][0] * v[i][0] + v[i][1] * v[i][1] + v[i][2] * v[i][2] + v[i][3] * v[i][3];
        ss = wave_sum(ss);
        const float inv = rsqrtf(ss * (1.f / 1024.f) + EPS);
#pragma unroll
        for (int i = 0; i < 4; ++i) { const int c = i * 256 + lane * 4;
            float o[4];
#pragma unroll
            for (int j = 0; j < 4; ++j) o[j] = v[i][j] * inv * gg[i][j] * (1.f + s1[i][j]) + s0[i][j];
            u32x2 w = {cvtpk(o[0], o[1]), cvtpk(o[2], o[3])};
            *(u32x2*)(H + (size_t)row * 1024 + c) = w; }
    }
}

constexpr int NGE = 3;
__device__ __forceinline__ void ph_gemm_in(KArgs a, int l, char* shm) {
    const bf16_t* H = (const bf16_t*)(a->ws + WS_H); const bf16_t* W = (const bf16_t*)(a->ws + WS_WIN);
    int R0, C0; stage_coords(R0, C0);
    const int nu = l == 0 ? 68 * (23 + NGE) : 64 * 23 + 4 * 13;
    const int G = gridDim.x, bx = blockIdx.x; const int ntl = bx < nu ? (nu - bx + G - 1) / G : 0;
    auto coords = [&](int k, int& i, int& j) { const int u = xcd_unit(k, nu);
        const int nr = l == 0 ? 68 : 64, nc = l == 0 ? 23 + NGE : 23;
        if (u < nr * nc) { const int w0 = (nc + 2) / 3, w1 = (nc - w0 + 1) / 2; int v = u, j0 = 0, w = w0;
            if (v >= nr * w0) { v -= nr * w0; j0 = w0; w = w1; if (v >= nr * w1) { v -= nr * w1; j0 = w0 + w1; w = nc - w0 - w1; } }
            const int il = v / w; j = j0 + v % w; i = l == 0 ? il : (il >> 4) * 17 + 1 + (il & 15); }
        else { const int v = u - 64 * 23; i = (v / 13) * 17; const int q = v % 13; j = q < 10 ? 8 + q : (q < 12 ? 20 + (q - 10) : 22); } };
    gemm_stream<AMapId>(1024, ntl,
      [&](int k, const bf16_t*& A, const bf16_t*& B, AMapId& am, unsigned& bo) { int i, j; coords(k, i, j); A = H; B = W; am = AMapId{(i * 256 + R0) * 1024 + C0, 1024}; bo = (unsigned)((j * 256 + bperm(R0)) * 1024 + C0) * 2u; },
      [&](int k, f32x4 (&acc)[2][2][4][2]) { int i, j; coords(k, i, j); EPI_LANES;
        if (j < 22) {
            size_t base; int wdt, c0;
            if (j < 12) { base = (size_t)(j >> 1) * 2 * U; wdt = 512; c0 = (j & 1) * 256; }
            else if (j == 12) { base = WS_AK; wdt = 256; c0 = 0; }
            else if (j == 13) { base = WS_AV; wdt = 256; c0 = 0; }
            else if (j < 18) { base = WS_XBC; wdt = 1024; c0 = (j - 14) * 256; }
            else if (j < 20) { base = WS_GQ; wdt = 512; c0 = (j - 18) * 256; }
            else { base = WS_GK; wdt = 512; c0 = (j - 20) * 256; }
            bf16_t* O = (bf16_t*)(a->ws + base);
#pragma unroll
            for (int ai = 0; ai < 2; ++ai)
#pragma unroll
                for (int m = 0; m < 4; ++m) { const int row = i * 256 + ai * 128 + wr * 64 + m * 16 + fr;
#pragma unroll
                    for (int bj = 0; bj < 2; ++bj) { const int col = c0 + bj * 128 + wc * 32 + fq * 8; const f32x4 v = acc[ai][bj][m][0], v2 = acc[ai][bj][m][1];
                            u32x4 w = {cvtpk(v[0], v[1]), cvtpk(v[2], v[3]), cvtpk(v2[0], v2[1]), cvtpk(v2[2], v2[3])}; *(u32x4*)(O + (size_t)row * wdt + col) = w; } }
        } else if (j == 22) {
            float* O = (float*)(a->ws + WS_SM);
#pragma unroll
            for (int ai = 0; ai < 2; ++ai)
#pragma unroll
                for (int m = 0; m < 4; ++m) { const int row = i * 256 + ai * 128 + wr * 64 + m * 16 + fr;
#pragma unroll
                    for (int n = 0; n < 2; ++n) { const int col = wc * 32 + fq * 8 + n * 4;
                        if (col < 48) *(f32x4*)(O + (size_t)row * 48 + col) = acc[ai][0][m][n]; } }
        } else {
            bf16_t* O = (bf16_t*)(a->ws + WS_GE); const int c0 = (j - 23) * 256;
#pragma unroll
            for (int ai = 0; ai < 2; ++ai)
#pragma unroll
                for (int m = 0; m < 4; ++m) { const int row = i * 256 + ai * 128 + wr * 64 + m * 16 + fr;
#pragma unroll
                    for (int bj = 0; bj < 2; ++bj) { const int col = c0 + bj * 128 + wc * 32 + fq * 8; const f32x4 v = acc[ai][bj][m][0], v2 = acc[ai][bj][m][1];
                            u32x4 w = {cvtpk(sigmoidf_(v[0]), sigmoidf_(v[1])), cvtpk(sigmoidf_(v[2]), sigmoidf_(v[3])), cvtpk(sigmoidf_(v2[0]), sigmoidf_(v2[1])), cvtpk(sigmoidf_(v2[2]), sigmoidf_(v2[3]))};
                            *(u32x4*)(O + (size_t)row * (NGE * 256) + col) = w; } }
        }
      }, shm);
}
__device__ __forceinline__ void ph_gemm_gates(KArgs a, int l, char* shm) {
    const bf16_t* H = (const bf16_t*)(a->ws + WS_H); const bf16_t* W = (const bf16_t*)(a->ws + WS_WIN) + (size_t)5888 * 1024;
    int R0, C0; stage_coords(R0, C0);
    const int j0 = l == 0 ? NGE : 0, nj = 16 - j0;
    const int nrt = n_row_tiles(l); const int nu = nrt * nj; const int G = gridDim.x, bx = blockIdx.x;
    const int ntl = bx < nu ? (nu - bx + G - 1) / G : 0;
    auto coords = [&](int k, int& i, int& j) { int v = xcd_unit(k, nu); const int w0 = (nj + 1) >> 1; int jb = 0, w = w0; if (v >= nrt * w0) { v -= nrt * w0; jb = w0; w = nj - w0; } i = v / w; j = j0 + jb + v % w; };
    gemm_stream<AMapId>(1024, ntl,
        [&](int k, const bf16_t*& A, const bf16_t*& B, AMapId& am, unsigned& bo) { int i, j; coords(k, i, j); A = H; B = W; am = AMapId{(row_tile_base(l, i) + R0) * 1024 + C0, 1024}; bo = (unsigned)((j * 256 + bperm(R0)) * 1024 + C0) * 2u; },
        [&](int k, f32x4 (&acc)[2][2][4][2]) { int i, j; coords(k, i, j); const int rb = row_tile_base(l, i); EPI_LANES;
            bf16_t* O = (bf16_t*)(a->ws + WS_GATES + (size_t)(j >> 2) * 4 * U); const int c0 = (j & 3) * 256;
#pragma unroll
            for (int ai = 0; ai < 2; ++ai)
#pragma unroll
                for (int m = 0; m < 4; ++m) { const int row = rb + ai * 128 + wr * 64 + m * 16 + fr;
#pragma unroll
                    for (int bj = 0; bj < 2; ++bj) { const int col = c0 + bj * 128 + wc * 32 + fq * 8; const f32x4 v = acc[ai][bj][m][0], v2 = acc[ai][bj][m][1];
                            u32x4 w = {cvtpk(sigmoidf_(v[0]), sigmoidf_(v[1])), cvtpk(sigmoidf_(v[2]), sigmoidf_(v[3])), cvtpk(sigmoidf_(v2[0]), sigmoidf_(v2[1])), cvtpk(sigmoidf_(v2[2]), sigmoidf_(v2[3]))};
                            *(u32x4*)(O + (size_t)row * 1024 + col) = w; } } },
        shm);
}

namespace lru {
constexpr int TS = 128, NT = SEQ / TS;
constexpr int OFF_U = 0, OFF_WA = 16384, OFF_WX = 24576, OFF_AT = 32768, OFF_VT = 65536, OFF_HF = 98304, OFF_COMP = LDS_MAIN + 256, OFF_H0 = OFF_COMP + 4096;
__device__ __forceinline__ int uswz(int row, int cb) { return row * 128 + (cb ^ ((row & 7) << 4)); }
__device__ __forceinline__ int crow(int r, int hi) { return (r & 3) + 8 * (r >> 2) + 4 * hi; }
__device__ __forceinline__ float* sum_ptr(KArgs a, int b, int dir, int t) { return (float*)(a->ws + WS_LSUM) + ((size_t)((b * 2 + dir) * NT + t)) * 1024; }
__device__ __forceinline__ void conv_u(KArgs a, int l, int b, int t, int n, char* shm, int tid) {
    const bf16_t* LX = (const bf16_t*)(a->ws + WS_LX); const int pb = t * TS; const int slo = t < 2 ? 0 : CTX, shi = t < 2 ? CTX : SEQ;
    const int sg = tid & 7, ch0 = n * 64 + sg * 8;
    float cw[4][8], cb[8];
#pragma unroll
    for (int k = 0; k < 4; ++k) { const f32x4 w0 = *(const f32x4*)(a->in[18] + (l * 4 + k) * 512 + ch0), w1 = *(const f32x4*)(a->in[18] + (l * 4 + k) * 512 + ch0 + 4);
#pragma unroll
        for (int j = 0; j < 4; ++j) { cw[k][j] = w0[j]; cw[k][4 + j] = w1[j]; } }
    { const f32x4 b0 = *(const f32x4*)(a->in[19] + l * 512 + ch0), b1 = *(const f32x4*)(a->in[19] + l * 512 + ch0 + 4);
#pragma unroll
      for (int j = 0; j < 4; ++j) { cb[j] = b0[j]; cb[4 + j] = b1[j]; } }
#pragma unroll
    for (int q = 0; q < 2; ++q) { const int pos = (tid >> 3) + q * 64; float u[8];
#pragma unroll
        for (int j = 0; j < 8; ++j) u[j] = cb[j];
#pragma unroll
        for (int k = 0; k < 4; ++k) { const int p = pb + pos + k - 2;
            if (p >= slo && p < shi) { const u32x4 xv = *(const u32x4*)(LX + (size_t)(b * SEQ + p) * 512 + ch0);
#pragma unroll
                for (int j = 0; j < 4; ++j) { u[2 * j] += cw[k][2 * j] * lo_bf(xv[j]); u[2 * j + 1] += cw[k][2 * j + 1] * hi_bf(xv[j]); } } }
        u32x4 o = {cvtpk(u[0], u[1]), cvtpk(u[2], u[3]), cvtpk(u[4], u[5]), cvtpk(u[6], u[7])};
        *(u32x4*)(shm + OFF_U + uswz(pos, sg * 16)) = o; }
}
__device__ __forceinline__ bf16_t* la_ptr(KArgs a, int dir) { return (bf16_t*)(a->ws + (dir ? WS_E13 : WS_TMP + 4 * U)); }
__device__ __forceinline__ bf16_t* lv_ptr(KArgs a, int dir) { return (bf16_t*)(a->ws + (dir ? WS_E13 : WS_TMP + 4 * U) + 2 * U); }
__device__ __forceinline__ void composites(int dir, char* shm, int tid) {
    const float* at = (const float*)(shm + OFF_AT); const float* vt = (const float*)(shm + OFF_VT);
    const int cc = tid & 63, sgm = tid >> 6; float A = 1.f, H = 0.f;
#pragma unroll
    for (int i = 0; i < 16; ++i) { const int w = sgm * 16 + i; const int pos = dir ? 127 - w : w; const float av = at[pos * 64 + cc]; H = av * H + vt[pos * 64 + cc]; A *= av; }
    float* comp = (float*)(shm + OFF_COMP); comp[(sgm * 64 + cc) * 2] = A; comp[(sgm * 64 + cc) * 2 + 1] = H;
    __syncthreads();
}
struct LruW { u32x4 oa, ox; float ba, bx, lam8; };
__device__ __forceinline__ LruW lru_weights(KArgs a, int l, int n, int dir, int tid) { LruW w;
    const int c = tid & 63, kg = tid >> 6; const float* pa = a->in[20] + ((size_t)((l * 2 + dir) * 8 + n)) * 4096 + c; const float* px = a->in[22] + ((size_t)((l * 2 + dir) * 8 + n)) * 4096 + c;
    float va[8], vx[8];
#pragma unroll
    for (int j = 0; j < 8; ++j) { va[j] = pa[(kg * 8 + j) * 64]; vx[j] = px[(kg * 8 + j) * 64]; }
    w.oa = (u32x4){cvtpk(va[0], va[1]), cvtpk(va[2], va[3]), cvtpk(va[4], va[5]), cvtpk(va[6], va[7])}; w.ox = (u32x4){cvtpk(vx[0], vx[1]), cvtpk(vx[2], vx[3]), cvtpk(vx[4], vx[5]), cvtpk(vx[6], vx[7])};
    const int ch = n * 64 + ((tid >> 6) & 1) * 32 + (tid & 31);
    w.ba = a->in[21][(l * 2 + dir) * 512 + ch]; w.bx = a->in[23][(l * 2 + dir) * 512 + ch]; w.lam8 = -8.f * softplus_rel(-a->in[24][(l * 2 + dir) * 512 + ch]);
    return w; }
__device__ __forceinline__ void gates_dir(const LruW& lw, char* shm, int tid) {
    const int wid = tid >> 6, lane = tid & 63, r32 = lane & 31, hi = lane >> 5;
    { const int c = tid & 63, kg = tid >> 6; *(u32x4*)(shm + OFF_WA + uswz(c, kg * 16)) = lw.oa; *(u32x4*)(shm + OFF_WX + uswz(c, kg * 16)) = lw.ox; }
    __syncthreads();
    const int rb = wid >> 1, cbk = wid & 1;
    f32x16 accA = {}, accX = {};
#pragma unroll
    for (int ks = 0; ks < 4; ++ks) { const int cb = (ks * 16 + hi * 8) * 2;
        const bf16x8 fu = *(const bf16x8*)(shm + OFF_U + uswz(rb * 32 + r32, cb)), fa = *(const bf16x8*)(shm + OFF_WA + uswz(cbk * 32 + r32, cb)), fx = *(const bf16x8*)(shm + OFF_WX + uswz(cbk * 32 + r32, cb));
        accA = __builtin_amdgcn_mfma_f32_32x32x16_bf16(fu, fa, accA, 0, 0, 0); accX = __builtin_amdgcn_mfma_f32_32x32x16_bf16(fu, fx, accX, 0, 0, 0); }
    const int c = cbk * 32 + r32;
    const float ba = lw.ba, bx = lw.bx, lam8 = lw.lam8;
    float* at = (float*)(shm + OFF_AT); float* vt = (float*)(shm + OFF_VT); float* lt = (float*)(shm + OFF_HF);
#pragma unroll
    for (int r = 0; r < 16; ++r) { const int pos = rb * 32 + crow(r, hi);
        const float rg = sigmoidf_(accA[r] + ba), ig = sigmoidf_(accX[r] + bx); const float la = bf2f(f2bf(lam8 * rg)); const float x2 = 2.f * la;
        const float om = x2 > -0.02f ? -x2 * (1.f + x2 * (0.5f + x2 * (0.16666667f + x2 * 0.041666668f))) : 1.f - __expf(x2);
        const float uu = bf2f(*(const bf16_t*)(shm + OFF_U + uswz(pos, c * 2)));
        at[pos * 64 + c] = __expf(la); vt[pos * 64 + c] = bf2f(f2bf(uu * ig * __builtin_amdgcn_sqrtf(om))); lt[pos * 64 + c] = la; }
    __syncthreads();
}
__device__ __forceinline__ void pass_a(KArgs a, int l, char* shm) {
    LruW lw0 = {}, lw1 = {}; int ncur = -1;
    for (int u = blockIdx.x; u < NB * NT * 8; u += gridDim.x) { const int b = u / (NT * 8), rem = u % (NT * 8); const int t = rem >> 3, n = rem & 7;
        const int tid = ltid();
        if (n != ncur) { lw0 = lru_weights(a, l, n, 0, tid); lw1 = lru_weights(a, l, n, 1, tid); ncur = n; }
        conv_u(a, l, b, t, n, shm, tid);
        for (int dir = 0; dir < 2; ++dir) {
            gates_dir(dir ? lw1 : lw0, shm, tid);
            {
                const int pos = tid >> 2, c0 = (tid & 3) * 16; const float* lp = (const float*)(shm + OFF_HF) + pos * 64 + c0; const float* vp = (const float*)(shm + OFF_VT) + pos * 64 + c0;
                const size_t o = ((size_t)b * SEQ + t * TS + pos) * 512 + n * 64 + c0;
                u32x4 w0 = {cvtpk(lp[0], lp[1]), cvtpk(lp[2], lp[3]), cvtpk(lp[4], lp[5]), cvtpk(lp[6], lp[7])}, w1 = {cvtpk(lp[8], lp[9]), cvtpk(lp[10], lp[11]), cvtpk(lp[12], lp[13]), cvtpk(lp[14], lp[15])};
                *(u32x4*)(la_ptr(a, dir) + o) = w0; *(u32x4*)(la_ptr(a, dir) + o + 8) = w1;
                u32x4 x0 = {cvtpk(vp[0], vp[1]), cvtpk(vp[2], vp[3]), cvtpk(vp[4], vp[5]), cvtpk(vp[6], vp[7])}, x1 = {cvtpk(vp[8], vp[9]), cvtpk(vp[10], vp[11]), cvtpk(vp[12], vp[13]), cvtpk(vp[14], vp[15])};
                *(u32x4*)(lv_ptr(a, dir) + o) = x0; *(u32x4*)(lv_ptr(a, dir) + o + 8) = x1; }
            composites(dir, shm, tid);
            if (tid < 64) { const float* comp = (const float*)(shm + OFF_COMP); float A = 1.f, H = 0.f;
#pragma unroll
                for (int sg = 0; sg < 8; ++sg) { const float ca = comp[(sg * 64 + tid) * 2], chh = comp[(sg * 64 + tid) * 2 + 1]; H = ca * H + chh; A *= ca; }
                float* sp = sum_ptr(a, b, dir, t) + (n * 64 + tid) * 2; sp[0] = A; sp[1] = H; }
            __syncthreads();
        }
    }
}
__device__ __forceinline__ void pass_b(KArgs a, int l, char* shm) {
    bf16_t* LG = (bf16_t*)(a->ws + WS_LG);
    const int nub = l == 1 ? NB * (NT - 2) * 8 : NB * NT * 8;
    for (int u = blockIdx.x; u < nub; u += gridDim.x) { int b, rem; if (l == 1) { b = u / ((NT - 2) * 8); rem = u % ((NT - 2) * 8) + 16; } else { b = u / (NT * 8); rem = u % (NT * 8); } const int t = rem >> 3, n = rem & 7;
        const int tid = ltid();
        const int lpos = tid >> 2, lc0 = (tid & 3) * 16; const size_t lo = ((size_t)b * SEQ + t * TS + lpos) * 512 + n * 64 + lc0;
        bf16_t lgv[16];
        {   const int cc_ = tid & 63, sgm_ = tid >> 6;
#pragma unroll
            for (int i = 0; i < 16; ++i) { const int pos = 127 - (sgm_ * 16 + i); lgv[i] = LG[((size_t)b * SEQ + t * TS + pos) * 512 + n * 64 + cc_]; } }
        u32x4 rl[2][2], rv[2][2];
#pragma unroll
        for (int dir = 0; dir < 2; ++dir) { rl[dir][0] = *(const u32x4*)(la_ptr(a, dir) + lo); rl[dir][1] = *(const u32x4*)(la_ptr(a, dir) + lo + 8); rv[dir][0] = *(const u32x4*)(lv_ptr(a, dir) + lo); rv[dir][1] = *(const u32x4*)(lv_ptr(a, dir) + lo + 8); }
        {   float* stg = (float*)(shm + OFF_AT);
            f32x4 sv[5];
#pragma unroll
            for (int q = 0; q < 5; ++q) { const int i = tid + q * NTHREADS; const int ii = i < 2 * NT * 32 ? i : 0; const int dir = ii / (NT * 32), r = ii % (NT * 32); const int tt = r >> 5, c4 = r & 31;
                sv[q] = *(const f32x4*)(sum_ptr(a, b, dir, tt) + n * 128 + c4 * 4); }
#pragma unroll
            for (int q = 0; q < 5; ++q) { const int i = tid + q * NTHREADS; if (i < 2 * NT * 32) *(f32x4*)(stg + i * 4) = sv[q]; }
            __syncthreads();
            {   const int dir = (tid >> 6) & 1, c = tid & 63, sgq = tid >> 7; float A = 1.f, H = 0.f;
                int kt = 0; for (int k = 0; k < NT; ++k) { const int tt = dir == 0 ? k : (k < 2 ? 1 - k : NT + 1 - k); if (tt == t) { kt = k; break; } }
#pragma unroll
                for (int q = 0; q < 9; ++q) { const int k = sgq * 9 + q; if (k < kt && k < NT) { const int tt = dir == 0 ? k : (k < 2 ? 1 - k : NT + 1 - k);
                        const float* e = stg + ((dir * NT + tt) * 64 + c) * 2; H = e[0] * H + e[1]; A *= e[0]; } }
                float* cst = (float*)(shm + OFF_HF);
                cst[((sgq * 2 + dir) * 64 + c) * 2] = A; cst[((sgq * 2 + dir) * 64 + c) * 2 + 1] = H; }
            __syncthreads();
            if (tid < 128) { const int dir = tid >> 6, c = tid & 63; const float* cst = (const float*)(shm + OFF_HF); float h = 0.f;
#pragma unroll
                for (int q = 0; q < 4; ++q) { const float* e = cst + ((q * 2 + dir) * 64 + c) * 2; h = e[0] * h + e[1]; }
                ((float*)(shm + OFF_H0))[tid] = h; }
            __syncthreads();
        }
        for (int dir = 0; dir < 2; ++dir) {
            {   float* atw = (float*)(shm + OFF_AT) + lpos * 64 + lc0; float* vtw = (float*)(shm + OFF_VT) + lpos * 64 + lc0;
#pragma unroll
                for (int h2 = 0; h2 < 2; ++h2)
#pragma unroll
                    for (int e = 0; e < 4; ++e) { atw[h2 * 8 + 2 * e] = __expf(lo_bf(rl[dir][h2][e])); atw[h2 * 8 + 2 * e + 1] = __expf(hi_bf(rl[dir][h2][e])); vtw[h2 * 8 + 2 * e] = lo_bf(rv[dir][h2][e]); vtw[h2 * 8 + 2 * e + 1] = hi_bf(rv[dir][h2][e]); } }
            __syncthreads();
            composites(dir, shm, tid);
            const float* at = (const float*)(shm + OFF_AT); const float* vt = (const float*)(shm + OFF_VT); const float* comp = (const float*)(shm + OFF_COMP); float* hf = (float*)(shm + OFF_HF);
            const int cc = tid & 63, sgm = tid >> 6; float H = ((const float*)(shm + OFF_H0))[dir * 64 + cc];
            for (int sg = 0; sg < sgm; ++sg) H = comp[(sg * 64 + cc) * 2] * H + comp[(sg * 64 + cc) * 2 + 1];
#pragma unroll
            for (int i = 0; i < 16; ++i) { const int w = sgm * 16 + i; const int pos = dir ? 127 - w : w; H = at[pos * 64 + cc] * H + vt[pos * 64 + cc];
                if (dir == 0) hf[pos * 64 + cc] = H;
                else { const size_t row = (size_t)b * SEQ + t * TS + pos; LG[row * 512 + n * 64 + cc] = f2bf((hf[pos * 64 + cc] + H) * gelu_tanh(bf2f(lgv[i]))); } }
            __syncthreads();
        }
    }
}
}

__device__ __forceinline__ void ph_prep(KArgs a, int l, char* shm) {
    float* cw = (float*)shm;
    float* g2 = cw + 5 * 1024;
    float* gb = g2 + 2 * 16 * 512;
    const int tid = ltid(), lane = tid & 63, wv = tid >> 6;
    for (int i = tid; i < 4 * 1024; i += NTHREADS) cw[i] = a->in[9][l * 4096 + i];
    for (int i = tid; i < 1024; i += NTHREADS) cw[4096 + i] = a->in[10][l * 1024 + i];
    for (int i = tid; i < 2 * 16 * 512; i += NTHREADS) g2[i] = a->in[15][l * 2 * 16 * 512 + i];
    for (int i = tid; i < 1024; i += NTHREADS) gb[i] = a->in[16][l * 1024 + i];
    float* rtab = gb + 1024;
    for (int i = tid; i < 2048; i += NTHREADS) { const int p = i >> 5, f = i & 31; float sn, cs; sincosf((float)p * __builtin_amdgcn_exp2f(-(float)f * 0.41524101186092029f), &sn, &cs);     rtab[2 * i] = cs; rtab[2 * i + 1] = sn; }
    __syncthreads();
    const bf16_t* HF = (const bf16_t*)(a->ws + WS_HF); const bf16_t* HB = (const bf16_t*)(a->ws + WS_HB); bf16_t* LG = (bf16_t*)(a->ws + WS_LG);
    const bf16_t* XBC = (const bf16_t*)(a->ws + WS_XBC); bf16_t* XC = (bf16_t*)(a->ws + WS_XBCC);
    const float* SM = (const float*)(a->ws + WS_SM); float* DTV = (float*)(a->ws + WS_DTV); bf16_t* G = (bf16_t*)(a->ws + WS_G);
    bf16_t* AQ = (bf16_t*)(a->ws + WS_AQ); bf16_t* AK = (bf16_t*)(a->ws + WS_AK);
    const float* qn = a->in[25] + l * 128; const float* kn = a->in[26] + l * 128;
    const float qn1 = qn[(lane >> 5) * 64 + (lane & 31)], qn2 = qn[(lane >> 5) * 64 + (lane & 31) + 32], kn1 = kn[(lane >> 5) * 64 + (lane & 31)], kn2 = kn[(lane >> 5) * 64 + (lane & 31) + 32];
    const float dtb = a->in[11][l * 16 + (lane & 15)];
    for (int row = blockIdx.x * 8 + wv; row < T; row += gridDim.x * 8) {
        const int b = row / SEQ, pos = row - b * SEQ; const bool isctx = pos < CTX;
        __builtin_amdgcn_sched_barrier(0);
        const float smv = SM[(size_t)row * 48 + (lane & 15)];
        float x1v[6], x2v[6];
#pragma unroll
        for (int hd = 0; hd < 6; ++hd) { const bf16_t* base = hd < 4 ? AQ + (size_t)row * 512 + hd * 128 : AK + (size_t)row * 256 + (hd - 4) * 128; x1v[hd] = bf2f(base[(lane >> 5) * 64 + (lane & 31)]); x2v[hd] = bf2f(base[(lane >> 5) * 64 + (lane & 31) + 32]); }
        {   const int slo = isctx ? 0 : CTX, shi = isctx ? CTX : SEQ;
            u32x4 xt[2][4];
#pragma unroll
            for (int hh = 0; hh < 2; ++hh)
#pragma unroll
                for (int k = 0; k < 4; ++k) { const int p = pos + k - 2; const bool ok = p >= slo && p < shi; const u32x4 xv = *(const u32x4*)(XBC + (size_t)(b * SEQ + (ok ? p : pos)) * 1024 + hh * 512 + lane * 8);
                    xt[hh][k] = ok ? xv : (u32x4){0u, 0u, 0u, 0u}; }
#pragma unroll
            for (int hh = 0; hh < 2; ++hh) { const int c0 = hh * 512 + lane * 8; float accv[8];
#pragma unroll
                for (int j = 0; j < 8; ++j) accv[j] = cw[4096 + c0 + j];
#pragma unroll
                for (int k = 0; k < 4; ++k) { const u32x4 xv = xt[hh][k];
#pragma unroll
                        for (int j = 0; j < 4; ++j) { accv[2 * j] += cw[k * 1024 + c0 + 2 * j] * lo_bf(xv[j]); accv[2 * j + 1] += cw[k * 1024 + c0 + 2 * j + 1] * hi_bf(xv[j]); } }
                u32x4 o;
#pragma unroll
                for (int j = 0; j < 4; ++j) o[j] = cvtpk(siluf_(accv[2 * j]), siluf_(accv[2 * j + 1]));
                *(u32x4*)(XC + (size_t)row * 1024 + c0) = o; } }
        __builtin_amdgcn_sched_barrier(0);
        if (lane < 16) DTV[(size_t)row * 16 + lane] = softplus_fast(smv + dtb);
        __builtin_amdgcn_sched_barrier(0);
        {   const int hf = lane >> 5, i = lane & 31; const int t = pos - CTX; const int pp = isctx ? 0 : (hf ? (t & 63) : (t >> 6));
            float cs = rtab[(pp * 32 + i) * 2], sn = rtab[(pp * 32 + i) * 2 + 1];
            if (isctx) { sn = 0.f; cs = 1.f; }
#pragma unroll
            for (int hd = 0; hd < 6; ++hd) { bf16_t* base = hd < 4 ? AQ + (size_t)row * 512 + hd * 128 : AK + (size_t)row * 256 + (hd - 4) * 128;
                const int d1 = hf * 64 + i, d2 = d1 + 32; float x1 = x1v[hd], x2 = x2v[hd];
                const float ss = wave_sum(x1 * x1 + x2 * x2); const float r = rsqrtf(ss * (1.f / 128.f) + EPS);
                x1 = x1 * r * (hd < 4 ? qn1 : kn1); x2 = x2 * r * (hd < 4 ? qn2 : kn2);
                base[d1] = f2bf(x1 * cs - x2 * sn); base[d2] = f2bf(x1 * sn + x2 * cs); } }
    }
}

namespace att {
constexpr int DH = 128, NW = 8, QBLK = 32, KVBLK = 64;
constexpr float SCALE = 0.088388347648318440f, THR = 8.f;
constexpr int LDQ = 512, LDK = 256, LDO = 512;
constexpr size_t SHM_V = KVBLK * DH * 2, SHM_K = KVBLK * DH * 2, SHM_ATTN = 2 * SHM_V + 2 * SHM_K + NW * 64 * 4;
#define KSWZ(row, colB) ((row) * 256 + ((colB) ^ (((row) & 7) << 4)))
#define SBAR() __builtin_amdgcn_sched_barrier(0)
__device__ __forceinline__ int crow(int r, int hi) { return (r & 3) + 8 * (r >> 2) + 4 * hi; }
__device__ __forceinline__ void partialSM(f32x16& p0, f32x16& p1, float& m_reg, float& mn, float& alpha) {
  constexpr float C = SCALE * 1.4426950408889634f;
  float pmax = p0[0]; for (int r = 1; r < 16; ++r) pmax = fmaxf(pmax, p0[r]); for (int r = 0; r < 16; ++r) pmax = fmaxf(pmax, p1[r]);
  { auto rr = __builtin_amdgcn_permlane32_swap(__float_as_uint(pmax), __float_as_uint(pmax), false, false);
    pmax = fmaxf(__uint_as_float(rr[0]), __uint_as_float(rr[1])); }
  if (__builtin_expect(__all(pmax - m_reg <= THR / SCALE), 1)) { mn = m_reg; alpha = 1.f; }
  else { mn = fmaxf(m_reg, pmax); alpha = __builtin_amdgcn_exp2f((m_reg - mn) * C); m_reg = mn; }
  float mnC = -mn * C;
  for (int r = 0; r < 16; ++r) p0[r] = fmaf(p0[r], C, mnC); for (int r = 0; r < 16; ++r) p1[r] = fmaf(p1[r], C, mnC);
  for (int r = 0; r < 16; ++r) p0[r] = __builtin_amdgcn_exp2f(p0[r]);
}
__device__ __forceinline__ void finishSM(f32x16& p0, f32x16& p1, float alpha, float& l_reg, bf16x8& pa0, bf16x8& pa1, bf16x8& pa2, bf16x8& pa3) {
  for (int r = 0; r < 16; ++r) p1[r] = __builtin_amdgcn_exp2f(p1[r]);
  float ps = 0; for (int r = 0; r < 16; ++r) ps += p0[r]; for (int r = 0; r < 16; ++r) ps += p1[r];
  { auto rr = __builtin_amdgcn_permlane32_swap(__float_as_uint(ps), __float_as_uint(ps), false, false);
    ps = __uint_as_float(rr[0]) + __uint_as_float(rr[1]); }
  l_reg = l_reg * alpha + ps;
#define PK4(P, BASE, OUT) do { unsigned a0 = cvtpk_asm(P[BASE + 0], P[BASE + 1]), a1 = cvtpk_asm(P[BASE + 2], P[BASE + 3]);   \
    unsigned b0 = cvtpk_asm(P[BASE + 4], P[BASE + 5]), b1 = cvtpk_asm(P[BASE + 6], P[BASE + 7]);                              \
    auto r0 = __builtin_amdgcn_permlane32_swap(a0, b0, false, false); auto r1 = __builtin_amdgcn_permlane32_swap(a1, b1, false, false); \
    u32x4 w = {r0[0], r1[0], r0[1], r1[1]}; OUT = *reinterpret_cast<bf16x8*>(&w); } while (0)
  PK4(p0, 0, pa0); PK4(p0, 8, pa1); PK4(p1, 0, pa2); PK4(p1, 8, pa3);
#undef PK4
}
__device__ __forceinline__ void qkt(f32x16& p0, f32x16& p1, const bf16_t* Ks, const bf16x8* qr, int r32, int hi) {
  p0 = f32x16{}; p1 = f32x16{};
  for (int d0 = 0; d0 < 8; ++d0) { int cb = (d0 * 16 + hi * 8) * 2;
    bf16x8 b0 = *reinterpret_cast<const bf16x8*>((const char*)Ks + KSWZ(r32, cb));
    bf16x8 b1 = *reinterpret_cast<const bf16x8*>((const char*)Ks + KSWZ(32 + r32, cb));
    p0 = __builtin_amdgcn_mfma_f32_32x32x16_bf16(b0, qr[d0], p0, 0, 0, 0);
    p1 = __builtin_amdgcn_mfma_f32_32x32x16_bf16(b1, qr[d0], p1, 0, 0, 0); }
}
__device__ __forceinline__ int v_st(int k, int c) { const int kk = (k & ~0xC) | ((k & 4) << 1) | ((k & 8) >> 1); return ((kk >> 3) * 4 + (c >> 5)) * 512 + ((kk & 7) * 32 + (c & 31)) * 2; }
__device__ __forceinline__ int v_rd_base(int lane) { return ((lane & 3) << 3) | (((lane >> 2) & 3) << 6) | (((lane >> 4) & 1) << 5) | (((lane >> 5) & 1) << 8); }
constexpr int v_rd_off(int d0, int ks, int half) { return d0 * 512 + ks * 4096 + half * 2048; }
template <int OFF> __device__ __forceinline__ s16x4 tr_read(int vb) {
  s16x4 r; asm volatile("ds_read_b64_tr_b16 %0, %1 offset:%2" : "=&v"(r) : "v"(vb), "i"(OFF) : "memory"); return r;
}
template <int D0> __device__ __forceinline__ void pv_one(f32x16& od, int vb, bf16x8 pa0, bf16x8 pa1, bf16x8 pa2, bf16x8 pa3) {
  const s16x4 l0 = tr_read<v_rd_off(D0, 0, 0)>(vb), h0 = tr_read<v_rd_off(D0, 0, 1)>(vb), l1 = tr_read<v_rd_off(D0, 1, 0)>(vb), h1 = tr_read<v_rd_off(D0, 1, 1)>(vb);
  const s16x4 l2 = tr_read<v_rd_off(D0, 2, 0)>(vb), h2 = tr_read<v_rd_off(D0, 2, 1)>(vb), l3 = tr_read<v_rd_off(D0, 3, 0)>(vb), h3 = tr_read<v_rd_off(D0, 3, 1)>(vb);
  asm volatile("s_waitcnt lgkmcnt(0)" ::: "memory"); SBAR();
#define PK(L, H) (bf16x8){L[0], L[1], L[2], L[3], H[0], H[1], H[2], H[3]}
  od = __builtin_amdgcn_mfma_f32_32x32x16_bf16(pa0, PK(l0, h0), od, 0, 0, 0);
  od = __builtin_amdgcn_mfma_f32_32x32x16_bf16(pa1, PK(l1, h1), od, 0, 0, 0);
  od = __builtin_amdgcn_mfma_f32_32x32x16_bf16(pa2, PK(l2, h2), od, 0, 0, 0);
  od = __builtin_amdgcn_mfma_f32_32x32x16_bf16(pa3, PK(l3, h3), od, 0, 0, 0);
#undef PK
}
template <int D0> __device__ __forceinline__ void pv_oneT(f32x16& od, int vb, bf16x8 pa0, bf16x8 pa1, bf16x8 pa2, bf16x8 pa3) {
  const s16x4 l0 = tr_read<v_rd_off(D0, 0, 0)>(vb), h0 = tr_read<v_rd_off(D0, 0, 1)>(vb), l1 = tr_read<v_rd_off(D0, 1, 0)>(vb), h1 = tr_read<v_rd_off(D0, 1, 1)>(vb);
  const s16x4 l2 = tr_read<v_rd_off(D0, 2, 0)>(vb), h2 = tr_read<v_rd_off(D0, 2, 1)>(vb), l3 = tr_read<v_rd_off(D0, 3, 0)>(vb), h3 = tr_read<v_rd_off(D0, 3, 1)>(vb);
  asm volatile("s_waitcnt lgkmcnt(0)" ::: "memory"); SBAR();
#define PK(L, H) (bf16x8){L[0], L[1], L[2], L[3], H[0], H[1], H[2], H[3]}
  od = __builtin_amdgcn_mfma_f32_32x32x16_bf16(PK(l0, h0), pa0, od, 0, 0, 0);
  od = __builtin_amdgcn_mfma_f32_32x32x16_bf16(PK(l1, h1), pa1, od, 0, 0, 0);
  od = __builtin_amdgcn_mfma_f32_32x32x16_bf16(PK(l2, h2), pa2, od, 0, 0, 0);
  od = __builtin_amdgcn_mfma_f32_32x32x16_bf16(PK(l3, h3), pa3, od, 0, 0, 0);
#undef PK
}
__device__ __forceinline__ void pv_d0(f32x16* o, int vb, bf16x8 pa0, bf16x8 pa1, bf16x8 pa2, bf16x8 pa3) {
  pv_oneT<0>(o[0], vb, pa0, pa1, pa2, pa3); pv_oneT<1>(o[1], vb, pa0, pa1, pa2, pa3); pv_oneT<2>(o[2], vb, pa0, pa1, pa2, pa3); pv_oneT<3>(o[3], vb, pa0, pa1, pa2, pa3);
}
__device__ __forceinline__ void attn_dense_body(const bf16_t* __restrict__ Qb, const bf16_t* __restrict__ Kh, const bf16_t* __restrict__ Vh,
                                                bf16_t* __restrict__ Ob, int seq, char* lds) {
  const int tid = ltid(), wid = tid >> 6, lane = tid & 63, r32 = lane & 31, hi = lane >> 5;
  bf16_t* V_lds = (bf16_t*)lds; bf16_t* K_lds = (bf16_t*)(lds + 2 * SHM_V);
  float* ws = (float*)(lds + 2 * SHM_V + 2 * SHM_K) + wid * 64; float* li_l = ws; float* al_l = ws + 32;
  float m_reg = -1e30f, l_reg = 0; f32x16 o[4] = {}; bf16x8 qr[8];
  const bf16_t* Qw = Qb + (long)(wid * QBLK + r32) * LDQ + hi * 8;
#pragma unroll
  for (int d0 = 0; d0 < 8; ++d0) qr[d0] = *reinterpret_cast<const bf16x8*>(Qw + d0 * 16);
  const int sr = tid >> 4, sc = (tid & 15) * 8, vst0 = v_st(sr, sc), vst1 = v_st(32 + sr, sc);
  const int vb0 = (int)(uintptr_t)V_lds + v_rd_base(lane);
  struct { bf16x8 vs0, vs1, ks0, ks1; } sr_[2];
#define SLOAD(i, k0) do { sr_[i].vs0 = *(const bf16x8*)(&Vh[(long)((k0) + sr) * LDK + sc]); sr_[i].vs1 = *(const bf16x8*)(&Vh[(long)((k0) + 32 + sr) * LDK + sc]); \
    sr_[i].ks0 = *(const bf16x8*)(&Kh[(long)((k0) + sr) * LDK + sc]); sr_[i].ks1 = *(const bf16x8*)(&Kh[(long)((k0) + 32 + sr) * LDK + sc]); } while (0)
#define SWRITE(b, i) do { *(bf16x8*)((char*)V_lds + (b) * SHM_V + vst0) = sr_[i].vs0;          \
    *(bf16x8*)((char*)V_lds + (b) * SHM_V + vst1) = sr_[i].vs1; int kc = sc * 2;               \
    *(bf16x8*)((char*)K_lds + (b) * SHM_K + KSWZ(sr, kc)) = sr_[i].ks0;                       \
    *(bf16x8*)((char*)K_lds + (b) * SHM_K + KSWZ(32 + sr, kc)) = sr_[i].ks1; } while (0)
#define SWAIT() asm volatile("s_waitcnt vmcnt(4)" ::: "memory")
#define RESC(a) do { if (__any((a) < 1.f)) { for (int d = 0; d < 4; ++d) for (int r = 0; r < 16; ++r) o[d][r] *= (a); } } while (0)
  f32x16 pA0, pA1, pB0, pB1; float mnA, mnB, alA, alB; bf16x8 pa0, pa1, pa2, pa3; const int NT = seq / KVBLK;
  constexpr int SE = 0, SO = 1;
  SLOAD(SE, 0); asm volatile("s_waitcnt vmcnt(0)" ::: "memory"); SWRITE(0, SE); __syncthreads();
  qkt(pA0, pA1, K_lds, qr, r32, hi); partialSM(pA0, pA1, m_reg, mnA, alA);
  SLOAD(SO, KVBLK); if (2 < NT) SLOAD(SE, 2 * KVBLK);
  SWAIT(); SWRITE(1, SO); __syncthreads();
  for (int j = 1; j + 1 < NT; j += 2) {
    SBAR(); qkt(pB0, pB1, (bf16_t*)((char*)K_lds + SHM_K), qr, r32, hi);
    finishSM(pA0, pA1, alA, l_reg, pa0, pa1, pa2, pa3); SBAR();
    SLOAD(SO, (j + 2) * KVBLK); SBAR();
    pv_d0(o, vb0, pa0, pa1, pa2, pa3); partialSM(pB0, pB1, m_reg, mnB, alB);
    __syncthreads(); SWAIT(); SWRITE(0, SE);
    RESC(alB); __syncthreads();
    SBAR(); qkt(pA0, pA1, K_lds, qr, r32, hi);
    finishSM(pB0, pB1, alB, l_reg, pa0, pa1, pa2, pa3); SBAR();
    if (j + 3 < NT) SLOAD(SE, (j + 3) * KVBLK); SBAR();
    pv_d0(o, vb0 + (int)SHM_V, pa0, pa1, pa2, pa3); partialSM(pA0, pA1, m_reg, mnA, alA);
    __syncthreads(); SWAIT(); SWRITE(1, SO);
    RESC(alA); __syncthreads();
  }
  SBAR(); qkt(pB0, pB1, (bf16_t*)((char*)K_lds + SHM_K), qr, r32, hi);
  finishSM(pA0, pA1, alA, l_reg, pa0, pa1, pa2, pa3); SBAR();
  pv_d0(o, vb0, pa0, pa1, pa2, pa3); partialSM(pB0, pB1, m_reg, mnB, alB);
  __syncthreads(); RESC(alB);
  finishSM(pB0, pB1, alB, l_reg, pa0, pa1, pa2, pa3); SBAR();
  pv_d0(o, vb0 + (int)SHM_V, pa0, pa1, pa2, pa3);
  {   const float rl = __builtin_amdgcn_rcpf(l_reg);
      bf16_t* Ow = Ob + (long)(wid * QBLK + r32) * LDO + 4 * hi;
#pragma unroll
      for (int d0 = 0; d0 < 4; ++d0)
#pragma unroll
          for (int t = 0; t < 2; ++t) {
              const u32x2 A = {cvtpk(o[d0][8 * t] * rl, o[d0][8 * t + 1] * rl), cvtpk(o[d0][8 * t + 2] * rl, o[d0][8 * t + 3] * rl)}, B = {cvtpk(o[d0][8 * t + 4] * rl, o[d0][8 * t + 5] * rl), cvtpk(o[d0][8 * t + 6] * rl, o[d0][8 * t + 7] * rl)};
              *(u32x4*)(Ow + d0 * 32 + 16 * t + 4 * hi) = pair16(A, B); } }
  __syncthreads();
#undef SLOAD
#undef SWRITE
#undef SWAIT
#undef RESC
}
}


namespace ssd {
constexpr int NCH = SEQ / 128;
constexpr int OFF_CUM = LDS_MAIN + 256, OFF_DT = OFF_CUM + 4096, OFF_TOT = OFF_DT + 4096, OFF_SSQ = OFF_TOT + 64;
__device__ __forceinline__ size_t st_index(int b, int dir, int c, int head) { return ((size_t)((b * 2 + dir) * NCH + c) * 8 + head) * 8192; }
__device__ __forceinline__ void chunk_cums(KArgs a, int l, int b, int c, int g, char* shm, int tid) {
    float* cum = (float*)(shm + OFF_CUM); float* dts = (float*)(shm + OFF_DT); float* tot = (float*)(shm + OFF_TOT);
    const int w = tid >> 6, lane = tid & 63, h4 = w >> 1, dir = w & 1, head = g * 4 + h4;
    const float* DTV = (const float*)(a->ws + WS_DTV); const size_t r0 = (size_t)b * SEQ + c * 128;
    const float ah = -__expf(a->in[12][(l * 2 + dir) * 8 + head]);
    const float d0 = DTV[(r0 + 2 * lane) * 16 + dir * 8 + head], d1 = DTV[(r0 + 2 * lane + 1) * 16 + dir * 8 + head];
    const float v0 = d0 * ah, v1 = d1 * ah; float x = v0 + v1;
#pragma unroll
    for (int o = 1; o < 64; o <<= 1) { const float t = __shfl_up(x, o, 64); if (lane >= o) x += t; }
    const float tt = __shfl(x, 63, 64);
    float c0, c1;
    if (dir == 0) { c0 = x - v1; c1 = x; } else { c0 = tt - (x - v1) + v0; c1 = tt - x + v1; }
    cum[w * 128 + 2 * lane] = c0; cum[w * 128 + 2 * lane + 1] = c1; dts[w * 128 + 2 * lane] = d0; dts[w * 128 + 2 * lane + 1] = d1;
    if (lane == 0) tot[w] = tt;
}
__device__ __forceinline__ void s1_unit(KArgs a, int l, int b, int c, int g, char* shm) {
    const int tid = ltid(), wid = tid >> 6, lane = tid & 63, r32 = lane & 31, hi = lane >> 5;
    const bf16_t* XC = (const bf16_t*)(a->ws + WS_XBCC); const size_t r0 = (size_t)b * SEQ + c * 128;
    float* cum = (float*)(shm + OFF_CUM); float* dts = (float*)(shm + OFF_DT); float* tot = (float*)(shm + OFF_TOT);
    u32x4 rb_[4], rx_[8];
#pragma unroll
    for (int q = 0; q < 4; ++q) { const int sgi = tid + q * NTHREADS; rb_[q] = *(const u32x4*)(XC + (r0 + (sgi >> 4)) * 1024 + 512 + g * 128 + (sgi & 15) * 8); }
#pragma unroll
    for (int q = 0; q < 8; ++q) { const int sgi = tid + q * NTHREADS; rx_[q] = *(const u32x4*)(XC + (r0 + (sgi >> 5)) * 1024 + g * 256 + (sgi & 31) * 8); }
    chunk_cums(a, l, b, c, g, shm, tid);
#pragma unroll
    for (int q = 0; q < 4; ++q) { const int sgi = tid + q * NTHREADS; const int j = sgi >> 4, n0 = (sgi & 15) * 8;
        *(u32x4*)(shm + (j >> 6) * 16384 + att::v_st(j & 63, n0)) = rb_[q]; }
    __syncthreads();
    const int h4 = wid >> 1, nhalf = wid & 1, head = g * 4 + h4;
    bf16_t* SST = (bf16_t*)(a->ws + WS_SST); float* CD = (float*)(a->ws + WS_CD);
    for (int dir = 0; dir < 2; ++dir) {
#pragma unroll
        for (int q = 0; q < 8; ++q) { const int sgi = tid + q * NTHREADS; const int j = sgi >> 5, c0 = (sgi & 31) * 8; const int hh = c0 >> 6;
            const u32x4 v = rx_[q];
            const int wq = hh * 2 + dir; const float u = __expf(tot[wq] - cum[wq * 128 + j]) * dts[wq * 128 + j];
            u32x4 o;
#pragma unroll
            for (int e = 0; e < 4; ++e) o[e] = cvtpk(lo_bf(v[e]) * u, hi_bf(v[e]) * u);
            *(u32x4*)(shm + 32768 + ((j >> 6) * 2 + (c0 >> 7)) * 16384 + att::v_st(j & 63, c0 & 127)) = o; }
        __syncthreads();
        f32x16 acc[2][2] = {};
        const int vbase = (int)(uintptr_t)shm + att::v_rd_base(lane);
#pragma unroll
        for (int kt = 0; kt < 2; ++kt) {
            const int vbB = vbase + kt * 16384 + (nhalf * 2) * 512;
            const int vbX = vbase + 32768 + (kt * 2 + (h4 >> 1)) * 16384 + ((h4 & 1) * 2) * 512;
#define S1_STEP(KS) { const s16x4 bl0 = att::tr_read<KS * 4096>(vbB), bh0 = att::tr_read<KS * 4096 + 2048>(vbB), bl1 = att::tr_read<KS * 4096>(vbB + 512), bh1 = att::tr_read<KS * 4096 + 2048>(vbB + 512); \
            const s16x4 xl0 = att::tr_read<KS * 4096>(vbX), xh0 = att::tr_read<KS * 4096 + 2048>(vbX), xl1 = att::tr_read<KS * 4096>(vbX + 512), xh1 = att::tr_read<KS * 4096 + 2048>(vbX + 512); \
            asm volatile("s_waitcnt lgkmcnt(0)" ::: "memory"); __builtin_amdgcn_sched_barrier(0); \
            const bf16x8 fb0 = S1_PK(bl0, bh0), fb1 = S1_PK(bl1, bh1), fx0 = S1_PK(xl0, xh0), fx1 = S1_PK(xl1, xh1); \
            acc[0][0] = __builtin_amdgcn_mfma_f32_32x32x16_bf16(fb0, fx0, acc[0][0], 0, 0, 0); acc[0][1] = __builtin_amdgcn_mfma_f32_32x32x16_bf16(fb0, fx1, acc[0][1], 0, 0, 0); \
            acc[1][0] = __builtin_amdgcn_mfma_f32_32x32x16_bf16(fb1, fx0, acc[1][0], 0, 0, 0); acc[1][1] = __builtin_amdgcn_mfma_f32_32x32x16_bf16(fb1, fx1, acc[1][1], 0, 0, 0); }
#define S1_PK(L, H) (bf16x8){L[0], L[1], L[2], L[3], H[0], H[1], H[2], H[3]}
            S1_STEP(0) S1_STEP(1) S1_STEP(2) S1_STEP(3)
#undef S1_STEP
#undef S1_PK
        }
        bf16_t* Sp = SST + st_index(b, dir, c, head);
#pragma unroll
        for (int nb = 0; nb < 2; ++nb)
#pragma unroll
            for (int pb = 0; pb < 2; ++pb) { const int p = pb * 32 + r32;
#pragma unroll
                for (int t = 0; t < 2; ++t) { const int n0 = nhalf * 64 + nb * 32 + 16 * t + 8 * hi; const f32x16& v = acc[nb][pb];
                    const u32x2 A = {cvtpk(v[8 * t], v[8 * t + 1]), cvtpk(v[8 * t + 2], v[8 * t + 3])}, B = {cvtpk(v[8 * t + 4], v[8 * t + 5]), cvtpk(v[8 * t + 6], v[8 * t + 7])};
                    *(u32x4*)(Sp + p * 128 + n0) = pair16(A, B); } }
        if (nhalf == 0 && lane == 0) CD[((b * 2 + dir) * NCH + c) * 8 + head] = __expf(tot[h4 * 2 + dir]);
        __syncthreads();
    }
}
__device__ __forceinline__ void s2_scan(KArgs a) {
    bf16_t* SST = (bf16_t*)(a->ws + WS_SST); const float* CD = (const float*)(a->ws + WS_CD);
    const int gt = blockIdx.x * NTHREADS + ltid();
    for (int e = gt; e < NB * 2 * 8 * 2048; e += gridDim.x * NTHREADS) {
        const int seg = e & 2047, head = (e >> 11) & 7, dir = (e >> 14) & 1, b = e >> 15;
        float h[4]; float zz = 0.f; asm volatile("" : "+v"(zz));
#pragma unroll
        for (int j = 0; j < 4; ++j) h[j] = zz;
        for (int k0 = 0; k0 < NCH; k0 += 4) { u32x2 sv[4]; float d[4]; bf16_t* p[4];
#pragma unroll
            for (int q = 0; q < 4; ++q) { const int k = k0 + q < NCH ? k0 + q : NCH - 1; const int c = dir == 0 ? k : (k < 2 ? 1 - k : NCH + 1 - k);
                p[q] = SST + st_index(b, dir, c, head) + seg * 4; sv[q] = *(const u32x2*)p[q]; d[q] = CD[((b * 2 + dir) * NCH + c) * 8 + head]; }
#pragma unroll
            for (int q = 0; q < 4; ++q) if (k0 + q < NCH) {
                u32x2 o = {cvtpk(h[0], h[1]), cvtpk(h[2], h[3])}; *(u32x2*)p[q] = o;
#pragma unroll
                for (int j = 0; j < 2; ++j) { h[2 * j] = d[q] * h[2 * j] + lo_bf(sv[q][j]); h[2 * j + 1] = d[q] * h[2 * j + 1] + hi_bf(sv[q][j]); } } }
    }
}
template <int HP> __device__ __forceinline__ void pv2(f32x16* od, int vb, bf16x8 pa0, bf16x8 pa1, bf16x8 pa2, bf16x8 pa3) {
    att::pv_oneT<HP * 2>(od[0], vb, pa0, pa1, pa2, pa3); att::pv_oneT<HP * 2 + 1>(od[1], vb, pa0, pa1, pa2, pa3);
}
__device__ __forceinline__ void s3_unit(KArgs a, int l, int b, int c, int g, char* shm) {
    const int tid = ltid(), wid = tid >> 6, lane = tid & 63, r32 = lane & 31, hi = lane >> 5;
    const bf16_t* XC = (const bf16_t*)(a->ws + WS_XBCC); const size_t r0 = (size_t)b * SEQ + c * 128;
    float* cum = (float*)(shm + OFF_CUM); float* dts = (float*)(shm + OFF_DT); float* ssq = (float*)(shm + OFF_SSQ);
    chunk_cums(a, l, b, c, g, shm, tid);
#pragma unroll
    for (int q = 0; q < 4; ++q) { const int sgi = tid + q * NTHREADS; const int j = sgi >> 4, n0 = (sgi & 15) * 8;
        const u32x4 v = *(const u32x4*)(XC + (r0 + j) * 1024 + 512 + g * 128 + n0);
        *(u32x4*)(shm + (j >> 6) * 16384 + KSWZ(j & 63, n0 * 2)) = v; }
#pragma unroll
    for (int q = 0; q < 8; ++q) { const int sgi = tid + q * NTHREADS; const int j = sgi >> 5, c0 = (sgi & 31) * 8;
        const u32x4 v = *(const u32x4*)(XC + (r0 + j) * 1024 + g * 256 + c0);
        *(u32x4*)(shm + 32768 + ((j >> 6) * 2 + (c0 >> 7)) * 16384 + att::v_st(j & 63, c0 & 127)) = v; }
#pragma unroll
    for (int q = 0; q < 4; ++q) { const int sgi = tid + q * NTHREADS; const int j = sgi >> 4, n0 = (sgi & 15) * 8;
        const u32x4 v = *(const u32x4*)(XC + (r0 + j) * 1024 + 768 + g * 128 + n0);
        *(u32x4*)(shm + 98304 + (j >> 6) * 16384 + KSWZ(j & 63, n0 * 2)) = v; }
    __syncthreads();
    const int h4 = wid >> 1, ihalf = wid & 1, head = g * 4 + h4;
    const bf16_t* SST = (const bf16_t*)(a->ws + WS_SST); bf16_t* Z = (bf16_t*)(a->ws + WS_Z);
    const float Dh = a->in[13][l * 8 + head]; const float* nw = a->in[14] + l * 512 + head * 64;
    const int vbase = (int)(uintptr_t)shm + att::v_rd_base(lane) + 32768 + (h4 >> 1) * 16384;
    for (int ib = ihalf * 2; ib < ihalf * 2 + 2; ++ib) {
        const int irow = ib * 32 + r32;
        bf16x8 qr[8];
#pragma unroll
        for (int d0 = 0; d0 < 8; ++d0) qr[d0] = *(const bf16x8*)(shm + 98304 + (irow >> 6) * 16384 + KSWZ(irow & 63, (d0 * 16 + hi * 8) * 2));
        f32x16 od[2] = {};
        for (int dir = 0; dir < 2; ++dir) {
            const float* cm = cum + (h4 * 2 + dir) * 128; const float* dd = dts + (h4 * 2 + dir) * 128; const float ci = cm[irow];
            bf16x8 hf0[8], hf1[8];
            {   const bf16_t* Hp = SST + st_index(b, dir, c, head) + (size_t)r32 * 128 + hi * 8;
#pragma unroll
                for (int d0 = 0; d0 < 8; ++d0) { hf0[d0] = *(const bf16x8*)(Hp + d0 * 16); hf1[d0] = *(const bf16x8*)(Hp + 32 * 128 + d0 * 16); } }
            for (int kt = 0; kt < 2; ++kt) {
                if (dir == 0 ? (kt * 64 > ib * 32 + 31) : (kt * 64 + 63 < ib * 32)) continue;
                f32x16 p0, p1; att::qkt(p0, p1, (const bf16_t*)(shm + kt * 16384), qr, r32, hi);
                int ir = dir == 0 ? irow : -irow; asm volatile("" : "+v"(ir));
#pragma unroll
                for (int r = 0; r < 16; ++r) { const int j0 = kt * 64 + att::crow(r, hi), j1 = j0 + 32;
                    const bool k0 = (dir == 0 ? j0 : -j0) <= ir, k1 = (dir == 0 ? j1 : -j1) <= ir;
                    p0[r] = k0 ? p0[r] * __expf(fminf(ci - cm[j0], 0.f)) * dd[j0] : 0.f; p1[r] = k1 ? p1[r] * __expf(fminf(ci - cm[j1], 0.f)) * dd[j1] : 0.f; }
                bf16x8 pa0, pa1, pa2, pa3;
#define PK4(P, BASE, OUT) do { unsigned a0 = cvtpk_asm(P[BASE + 0], P[BASE + 1]), a1 = cvtpk_asm(P[BASE + 2], P[BASE + 3]);   \
    unsigned b0 = cvtpk_asm(P[BASE + 4], P[BASE + 5]), b1 = cvtpk_asm(P[BASE + 6], P[BASE + 7]);                              \
    auto rr0 = __builtin_amdgcn_permlane32_swap(a0, b0, false, false); auto rr1 = __builtin_amdgcn_permlane32_swap(a1, b1, false, false); \
    u32x4 w_ = {rr0[0], rr1[0], rr0[1], rr1[1]}; OUT = *reinterpret_cast<bf16x8*>(&w_); } while (0)
                PK4(p0, 0, pa0); PK4(p0, 8, pa1); PK4(p1, 0, pa2); PK4(p1, 8, pa3);
#undef PK4
                __builtin_amdgcn_sched_barrier(0);
                if (h4 & 1) pv2<1>(od, vbase + kt * 32768, pa0, pa1, pa2, pa3); else pv2<0>(od, vbase + kt * 32768, pa0, pa1, pa2, pa3);
            }
            f32x16 of0 = {}, of1 = {};
#pragma unroll
            for (int d0 = 0; d0 < 8; ++d0) { of0 = __builtin_amdgcn_mfma_f32_32x32x16_bf16(hf0[d0], qr[d0], of0, 0, 0, 0); of1 = __builtin_amdgcn_mfma_f32_32x32x16_bf16(hf1[d0], qr[d0], of1, 0, 0, 0); }
            {   const float e = __expf(ci);
#pragma unroll
                for (int r = 0; r < 16; ++r) { od[0][r] += e * of0[r]; od[1][r] += e * of1[r]; } }
        }
        {   const size_t row = r0 + irow; const int cb = head * 64 + 4 * hi;
            u32x2 xv[2][4], zv[2][4]; f32x4 nv[2][4];
#pragma unroll
            for (int pb = 0; pb < 2; ++pb)
#pragma unroll
                for (int q = 0; q < 4; ++q) { const int col = cb + pb * 32 + 8 * q; xv[pb][q] = *(const u32x2*)(XC + row * 1024 + col); zv[pb][q] = *(const u32x2*)(Z + row * 512 + col); nv[pb][q] = *(const f32x4*)(nw + (col - head * 64)); }
            float sq = 0.f;
#pragma unroll
            for (int pb = 0; pb < 2; ++pb)
#pragma unroll
                for (int q = 0; q < 4; ++q) { const int col = cb + pb * 32 + 8 * q;
                    const float y0 = (od[pb][4 * q] + Dh * lo_bf(xv[pb][q][0])) * siluf_(lo_bf(zv[pb][q][0])), y1 = (od[pb][4 * q + 1] + Dh * hi_bf(xv[pb][q][0])) * siluf_(hi_bf(zv[pb][q][0]));
                    const float y2 = (od[pb][4 * q + 2] + Dh * lo_bf(xv[pb][q][1])) * siluf_(lo_bf(zv[pb][q][1])), y3 = (od[pb][4 * q + 3] + Dh * hi_bf(xv[pb][q][1])) * siluf_(hi_bf(zv[pb][q][1]));
                    sq += y0 * y0 + y1 * y1 + y2 * y2 + y3 * y3;
                    u32x2 w = {cvtpk(y0 * nv[pb][q][0], y1 * nv[pb][q][1]), cvtpk(y2 * nv[pb][q][2], y3 * nv[pb][q][3])}; *(u32x2*)(Z + row * 512 + col) = w; }
            sq += __shfl_xor(sq, 32, 64);
            if (hi == 0) ssq[h4 * 128 + irow] = sq; }
    }
    __syncthreads();
    if (tid < 128) ((float*)(a->ws + WS_SSQ))[(r0 + tid) * 2 + g] = (ssq[tid] + ssq[128 + tid]) + (ssq[256 + tid] + ssq[384 + tid]);
    __syncthreads();
}
}


namespace gla {
constexpr int NCH = SEQ / 64;
constexpr int OFF_GC = 65536;
constexpr int OFF_SSQ = OFF_GC + 32768;
constexpr int OFF_SEG = OFF_SSQ + 1024;
__device__ __forceinline__ bf16_t* st_ptr(KArgs a, int b, int dir, int c, int head) {
    return (bf16_t*)(a->ws + (dir ? WS_GST1 : WS_GST0)) + ((size_t)((b * NCH + c) * 4 + head)) * 16384; }
__device__ __forceinline__ float* tot_ptr(KArgs a, int b, int dir, int c, int head) { return (float*)(a->ws + WS_GTOT) + ((size_t)(((b * 2 + dir) * NCH + c) * 4 + head)) * 128; }
struct Ld2 { u32x4 v[2]; };
__device__ __forceinline__ Ld2 ld_tile(const bf16_t* base, int ld, size_t r0, int tid) { Ld2 o;
#pragma unroll
    for (int q = 0; q < 2; ++q) { const int sgi = tid + q * NTHREADS; o.v[q] = *(const u32x4*)(base + (r0 + (sgi >> 4)) * ld + (sgi & 15) * 8); }
    return o; }
struct GateOp { bf16x8 a[2], b[2]; float gb[2]; };
__device__ __forceinline__ GateOp ld_gate(KArgs a, int l, size_t r0, int head, int tid) { GateOp o;
    const int wid = tid >> 6, lane = tid & 63, r32 = lane & 31, hi = lane >> 5, rb = wid >> 2, cbk = wid & 3;
    const float* SM = (const float*)(a->ws + WS_SM); const bf16_t* G2T = (const bf16_t*)(a->ws + WS_G2T); const int kc = head * 128 + cbk * 32 + r32;
#pragma unroll
    for (int d = 0; d < 2; ++d) { const float* gp = SM + (r0 + rb * 32 + r32) * 48 + 16 + d * 16 + hi * 8; const f32x4 x0 = *(const f32x4*)gp, x1 = *(const f32x4*)(gp + 4);
        u32x4 w = {cvtpk(x0[0], x0[1]), cvtpk(x0[2], x0[3]), cvtpk(x1[0], x1[1]), cvtpk(x1[2], x1[3])}; o.a[d] = *reinterpret_cast<bf16x8*>(&w);
        o.b[d] = *(const bf16x8*)(G2T + ((size_t)d * 512 + kc) * 16 + hi * 8); o.gb[d] = a->in[16][(l * 2 + d) * 512 + kc]; }
    return o; }
__device__ __forceinline__ void make_gc(const GateOp& go, int dir, char* shm, int tid) {
    float* gc = (float*)(shm + OFF_GC); float* seg = (float*)(shm + OFF_SEG);
    {   const int wid = tid >> 6, lane = tid & 63, r32 = lane & 31, hi = lane >> 5, rb = wid >> 2, cbk = wid & 3;
        f32x16 lg = {}; lg = __builtin_amdgcn_mfma_f32_32x32x16_bf16(go.a[dir], go.b[dir], lg, 0, 0, 0);
#pragma unroll
        for (int r = 0; r < 16; ++r) gc[(rb * 32 + att::crow(r, hi)) * 128 + cbk * 32 + r32] = -softplus_fast(-(lg[r] + go.gb[dir])) * 0.0625f; }
    __syncthreads();
    const int k = tid & 127, sg = tid >> 7; float v[16]; float acc = 0.f;
#pragma unroll
    for (int i = 0; i < 16; ++i) { const int w = sg * 16 + i; const int l = dir ? 63 - w : w; acc += gc[l * 128 + k]; v[i] = acc; }
    seg[sg * 128 + k] = acc;
    __syncthreads();
    float off = 0.f;
#pragma unroll
    for (int j = 0; j < 3; ++j) off += j < sg ? seg[j * 128 + k] : 0.f;
#pragma unroll
    for (int i = 0; i < 16; ++i) { const int w = sg * 16 + i; const int l = dir ? 63 - w : w; gc[l * 128 + k] = v[i] + off; }
    __syncthreads();
}
__device__ __forceinline__ void g1_unit(KArgs a, int l_, int b, int c, int head, char* shm) {
    const int tid = ltid(), wid = tid >> 6, lane = tid & 63, r32 = lane & 31, hi = lane >> 5;
    const bf16_t* GK = (const bf16_t*)(a->ws + WS_GK); const bf16_t* GV = (const bf16_t*)(a->ws + WS_GV); const size_t r0 = (size_t)b * SEQ + c * 64;
    const float* gc = (const float*)(shm + OFF_GC);
    const Ld2 rv = ld_tile(GV + head * 128, 512, r0, tid), rk = ld_tile(GK + head * 128, 512, r0, tid);
    const GateOp go = ld_gate(a, l_, r0, head, tid);
#pragma unroll
    for (int q = 0; q < 2; ++q) { const int sgi = tid + q * NTHREADS; *(u32x4*)(shm + 16384 + att::v_st(sgi >> 4, (sgi & 15) * 8)) = rv.v[q]; }
    for (int dir = 0; dir < 2; ++dir) {
        make_gc(go, dir, shm, tid);
        const int lt = dir == 0 ? 63 : 0;
        if (tid < 128) tot_ptr(a, b, dir, c, head)[tid] = gc[lt * 128 + tid];
#pragma unroll
        for (int q = 0; q < 2; ++q) { const int sgi = tid + q * NTHREADS; const int l = sgi >> 4, k0 = (sgi & 15) * 8;
            const u32x4 kv = rk.v[q]; const float* gl = gc + l * 128 + k0; const float* gt = gc + lt * 128 + k0;
            u32x4 o;
#pragma unroll
            for (int e = 0; e < 4; ++e) o[e] = cvtpk(lo_bf(kv[e]) * __expf(gt[2 * e] - gl[2 * e]), hi_bf(kv[e]) * __expf(gt[2 * e + 1] - gl[2 * e + 1]));
            *(u32x4*)(shm + att::v_st(l, k0)) = o; }
        __syncthreads();
        const int kb = wid >> 1, vb0 = (wid & 1) * 2;
        f32x16 acc0 = {}, acc1 = {};
        const int vbase = (int)(uintptr_t)shm + att::v_rd_base(lane);
        const int vbK = vbase + kb * 512, vbV = vbase + 16384 + vb0 * 512;
#define G1_STEP(KS) { const s16x4 kl = att::tr_read<KS * 4096>(vbK), kh = att::tr_read<KS * 4096 + 2048>(vbK); \
            const s16x4 al = att::tr_read<KS * 4096>(vbV), ah = att::tr_read<KS * 4096 + 2048>(vbV), bl = att::tr_read<KS * 4096>(vbV + 512), bh = att::tr_read<KS * 4096 + 2048>(vbV + 512); \
            asm volatile("s_waitcnt lgkmcnt(0)" ::: "memory"); __builtin_amdgcn_sched_barrier(0); \
            const bf16x8 fk = G1_PK(kl, kh), fa = G1_PK(al, ah), fb = G1_PK(bl, bh); \
            acc0 = __builtin_amdgcn_mfma_f32_32x32x16_bf16(fk, fa, acc0, 0, 0, 0); acc1 = __builtin_amdgcn_mfma_f32_32x32x16_bf16(fk, fb, acc1, 0, 0, 0); }
#define G1_PK(L, H) (bf16x8){L[0], L[1], L[2], L[3], H[0], H[1], H[2], H[3]}
        G1_STEP(0) G1_STEP(1) G1_STEP(2) G1_STEP(3)
#undef G1_STEP
#undef G1_PK
        bf16_t* Sp = st_ptr(a, b, dir, c, head);
#pragma unroll
        for (int t = 0; t < 2; ++t) { const f32x16& v = t ? acc1 : acc0; const int vv = (vb0 + t) * 32 + r32;
#pragma unroll
            for (int t2 = 0; t2 < 2; ++t2) { const int k0 = kb * 32 + 16 * t2 + 8 * hi;
                const u32x2 A = {cvtpk(v[8 * t2], v[8 * t2 + 1]), cvtpk(v[8 * t2 + 2], v[8 * t2 + 3])}, B = {cvtpk(v[8 * t2 + 4], v[8 * t2 + 5]), cvtpk(v[8 * t2 + 6], v[8 * t2 + 7])};
                *(u32x4*)(Sp + vv * 128 + k0) = pair16(A, B); } }
        __syncthreads();
    }
}
__device__ __forceinline__ void g2_scan(KArgs a) {
    const int gt = blockIdx.x * NTHREADS + ltid();
    for (int e = gt; e < NB * 2 * 4 * 4096; e += gridDim.x * NTHREADS) {
        const int seg = e & 4095, head = (e >> 12) & 3, dir = (e >> 14) & 1, b = e >> 15; const int kk = (seg & 31) * 4;
        float h[4]; float zz = 0.f; asm volatile("" : "+v"(zz));
#pragma unroll
        for (int j = 0; j < 4; ++j) h[j] = zz;
        for (int k0 = 0; k0 < NCH; k0 += 4) { u32x2 sv[4]; f32x4 t0[4]; bf16_t* p[4];
#pragma unroll
            for (int q = 0; q < 4; ++q) { const int k = k0 + q; const int c = dir == 0 ? k : (k < 4 ? 3 - k : NCH + 3 - k);
                p[q] = st_ptr(a, b, dir, c, head) + seg * 4; sv[q] = *(const u32x2*)p[q]; t0[q] = *(const f32x4*)(tot_ptr(a, b, dir, c, head) + kk); }
#pragma unroll
            for (int q = 0; q < 4; ++q) {
                u32x2 o = {cvtpk(h[0], h[1]), cvtpk(h[2], h[3])}; *(u32x2*)p[q] = o;
#pragma unroll
                for (int j = 0; j < 2; ++j) { h[2 * j] = __expf(t0[q][2 * j]) * h[2 * j] + lo_bf(sv[q][j]); h[2 * j + 1] = __expf(t0[q][2 * j + 1]) * h[2 * j + 1] + hi_bf(sv[q][j]); } } }
    }
}
template <int VB> __device__ __forceinline__ void pv1(f32x16& od, int vb, bf16x8 pa0, bf16x8 pa1, bf16x8 pa2, bf16x8 pa3) { att::pv_oneT<VB>(od, vb, pa0, pa1, pa2, pa3); }
__device__ __forceinline__ void g3_unit(KArgs a, int l_, int b, int c, int head, char* shm) {
    const int tid = ltid(), wid = tid >> 6, lane = tid & 63, r32 = lane & 31, hi = lane >> 5;
    const bf16_t* GQ = (const bf16_t*)(a->ws + WS_GQ); const bf16_t* GK = (const bf16_t*)(a->ws + WS_GK); const bf16_t* GV = (const bf16_t*)(a->ws + WS_GV);
    bf16_t* GR = (bf16_t*)(a->ws + WS_GR); const size_t r0 = (size_t)b * SEQ + c * 64;
    const float* gc = (const float*)(shm + OFF_GC); float* ssq = (float*)(shm + OFF_SSQ);
    const Ld2 rvt = ld_tile(GV + head * 128, 512, r0, tid), rq = ld_tile(GQ + head * 128, 512, r0, tid), rk = ld_tile(GK + head * 128, 512, r0, tid);
    const GateOp go = ld_gate(a, l_, r0, head, tid);
#pragma unroll
    for (int q = 0; q < 2; ++q) { const int sgi = tid + q * NTHREADS; *(u32x4*)(shm + 49152 + att::v_st(sgi >> 4, (sgi & 15) * 8)) = rvt.v[q]; }
    const int ib = wid >> 2, vb = wid & 3;
    f32x16 od = {};
    for (int dir = 0; dir < 2; ++dir) {
        bf16x8 sbf[8];
        {   const bf16_t* Sp = st_ptr(a, b, dir, c, head) + (size_t)(vb * 32 + r32) * 128 + hi * 8;
#pragma unroll
            for (int d0 = 0; d0 < 8; ++d0) sbf[d0] = *(const bf16x8*)(Sp + d0 * 16); }
        make_gc(go, dir, shm, tid);
        const int lref = dir == 0 ? 32 : 31;
#pragma unroll
        for (int q = 0; q < 2; ++q) { const int sgi = tid + q * NTHREADS; const int l = sgi >> 4, k0 = (sgi & 15) * 8;
            const u32x4 kv = rk.v[q], qv = rq.v[q];
            const float* gl = gc + l * 128 + k0; const float* gr_ = gc + lref * 128 + k0;
            u32x4 ok, oq, ot;
#pragma unroll
            for (int e = 0; e < 4; ++e) { const float d0 = gl[2 * e] - gr_[2 * e], d1 = gl[2 * e + 1] - gr_[2 * e + 1];
                ok[e] = cvtpk(lo_bf(kv[e]) * __expf(-d0), hi_bf(kv[e]) * __expf(-d1));
                oq[e] = cvtpk(lo_bf(qv[e]) * __expf(d0), hi_bf(qv[e]) * __expf(d1));
                ot[e] = cvtpk(lo_bf(qv[e]) * __expf(gl[2 * e]), hi_bf(qv[e]) * __expf(gl[2 * e + 1])); }
            const int sw = KSWZ(l, k0 * 2);
            *(u32x4*)(shm + sw) = ok; *(u32x4*)(shm + 16384 + sw) = oq; *(u32x4*)(shm + 32768 + sw) = ot; }
        __syncthreads();
        {   bf16x8 qr[8];
#pragma unroll
            for (int d0 = 0; d0 < 8; ++d0) qr[d0] = *(const bf16x8*)(shm + 16384 + KSWZ(ib * 32 + r32, (d0 * 16 + hi * 8) * 2));
            f32x16 p0, p1; att::qkt(p0, p1, (const bf16_t*)shm, qr, r32, hi);
            int ir = dir == 0 ? (ib * 32 + r32) : -(ib * 32 + r32); asm volatile("" : "+v"(ir));
#pragma unroll
            for (int r = 0; r < 16; ++r) { const int j0 = att::crow(r, hi), j1 = j0 + 32;
                p0[r] = ((dir == 0 ? j0 : -j0) <= ir) ? p0[r] : 0.f; p1[r] = ((dir == 0 ? j1 : -j1) <= ir) ? p1[r] : 0.f; }
            bf16x8 pa0, pa1, pa2, pa3;
#define PK4(P, BASE, OUT) do { unsigned a0 = cvtpk_asm(P[BASE + 0], P[BASE + 1]), a1 = cvtpk_asm(P[BASE + 2], P[BASE + 3]);   \
    unsigned b0 = cvtpk_asm(P[BASE + 4], P[BASE + 5]), b1 = cvtpk_asm(P[BASE + 6], P[BASE + 7]);                              \
    auto rr0 = __builtin_amdgcn_permlane32_swap(a0, b0, false, false); auto rr1 = __builtin_amdgcn_permlane32_swap(a1, b1, false, false); \
    u32x4 w_ = {rr0[0], rr1[0], rr0[1], rr1[1]}; OUT = *reinterpret_cast<bf16x8*>(&w_); } while (0)
            PK4(p0, 0, pa0); PK4(p0, 8, pa1); PK4(p1, 0, pa2); PK4(p1, 8, pa3);
#undef PK4
            __builtin_amdgcn_sched_barrier(0);
            const int vbb = (int)(uintptr_t)shm + att::v_rd_base(lane) + 49152;
            if (vb == 0) pv1<0>(od, vbb, pa0, pa1, pa2, pa3); else if (vb == 1) pv1<1>(od, vbb, pa0, pa1, pa2, pa3);
            else if (vb == 2) pv1<2>(od, vbb, pa0, pa1, pa2, pa3); else pv1<3>(od, vbb, pa0, pa1, pa2, pa3);
        }
        {
#pragma unroll
            for (int d0 = 0; d0 < 8; ++d0) { const bf16x8 qa = *(const bf16x8*)(shm + 32768 + KSWZ(ib * 32 + r32, (d0 * 16 + hi * 8) * 2));
                od = __builtin_amdgcn_mfma_f32_32x32x16_bf16(sbf[d0], qa, od, 0, 0, 0); } }
        __syncthreads();
    }
    const float qs = 0.08838834764831845f; const int irow = ib * 32 + r32; const size_t row = r0 + irow; const int cb = head * 128 + vb * 32 + 4 * hi;
    float sq = 0.f;
#pragma unroll
    for (int r = 0; r < 16; ++r) { od[r] *= qs; sq += od[r] * od[r]; }
    sq += __shfl_xor(sq, 32, 64);
    if (hi == 0) ssq[vb * 64 + irow] = sq;
    u32x2 rv[4]; f32x4 nv[4];
#pragma unroll
    for (int q = 0; q < 4; ++q) { rv[q] = *(const u32x2*)(GR + row * 512 + cb + 8 * q); nv[q] = *(const f32x4*)(a->in[17] + l_ * 512 + cb + 8 * q); }
    __syncthreads();
    const float inv = rsqrtf(((ssq[irow] + ssq[64 + irow]) + (ssq[128 + irow] + ssq[192 + irow])) * (1.f / 128.f) + EPS);
    u32x2 wq[4];
#pragma unroll
    for (int q = 0; q < 4; ++q)
        wq[q] = (u32x2){cvtpk(od[4 * q] * inv * nv[q][0] * siluf_(lo_bf(rv[q][0])), od[4 * q + 1] * inv * nv[q][1] * siluf_(hi_bf(rv[q][0]))),
                        cvtpk(od[4 * q + 2] * inv * nv[q][2] * siluf_(lo_bf(rv[q][1])), od[4 * q + 3] * inv * nv[q][3] * siluf_(hi_bf(rv[q][1])))};
#pragma unroll
    for (int t = 0; t < 2; ++t) *(u32x4*)(GR + row * 512 + cb + 16 * t + 4 * hi) = pair16(wq[2 * t], wq[2 * t + 1]);
    __syncthreads();
}
}

__device__ __forceinline__ void ph_mix(KArgs a, int l, char* shm) {
    const int natt = l == 0 ? 272 : 256;
    const bf16_t* AQ = (const bf16_t*)(a->ws + WS_AQ); const bf16_t* AK = (const bf16_t*)(a->ws + WS_AK); const bf16_t* AV = (const bf16_t*)(a->ws + WS_AV);
    for (int u = blockIdx.x; u < natt + 272 + 1088; u += gridDim.x) {
        if (u < natt) { const int v = u;
            if (v < 256) { const int b = v >> 6, hd = (v >> 4) & 3, qb = v & 15; const size_t r0 = (size_t)b * SEQ;
                att::attn_dense_body(AQ + (r0 + CTX + qb * 256) * 512 + hd * 128, AK + r0 * 256 + (hd >> 1) * 128, AV + r0 * 256 + (hd >> 1) * 128,
                                     (bf16_t*)AQ + (r0 + CTX + qb * 256) * 512 + hd * 128, SEQ, shm); }
            else { const int w = v - 256; const int b = w >> 2, hd = w & 3; const size_t r0 = (size_t)b * SEQ;
                att::attn_dense_body(AQ + r0 * 512 + hd * 128, AK + r0 * 256 + (hd >> 1) * 128, AV + r0 * 256 + (hd >> 1) * 128, (bf16_t*)AQ + r0 * 512 + hd * 128, CTX, shm); } }
        else if (u < natt + 272) { const int v = u - natt; const int b = v / 68, rem = v % 68; ssd::s1_unit(a, l, b, rem >> 1, rem & 1, shm); }
        else { const int v = u - natt - 272; const int b = v / 272, rem = v % 272; gla::g1_unit(a, l, b, rem >> 2, rem & 3, shm); }
    }
}
__device__ __forceinline__ void ph_ssd3(KArgs a, int l, char* shm) {
    const int nu = l == 0 ? 272 : 256;
    for (int k = blockIdx.x; k < nu; k += gridDim.x) { int b, rem; if (l == 0) { b = k / 68; rem = k % 68; } else { b = k >> 6; rem = (k & 63) + 4; }
        ssd::s3_unit(a, l, b, rem >> 1, rem & 1, shm); }
}
__device__ __forceinline__ void ph_gla3(KArgs a, int l, char* shm) {
    const int nu = l == 0 ? 1088 : 1024; const int G = gridDim.x, bx = blockIdx.x;
    const int fb = (l == 0 && G > 32) ? 16 : 0;
    if (bx < fb) return;
    for (int k = bx - fb; k < nu; k += G - fb) { int b, rem; if (l == 0) { b = k / 272; rem = k % 272; } else { b = k >> 8; rem = (k & 255) + 16; }
        gla::g3_unit(a, l, b, rem >> 2, rem & 3, shm); }
}

__device__ __forceinline__ void ph_merge(KArgs a, int l, char* shm) {
    int R0, C0; stage_coords(R0, C0);
    const int nrt = n_row_tiles(l);
    bf16_t* ACC = (bf16_t*)(a->ws + WS_H);
    for (int k = 0; ; ++k) { const int u = xcd_unit(k, nrt * 4); if (u >= nrt * 4) break;
        const int i = u >> 2, j = u & 3; const int rb = row_tile_base(l, i);
        f32x4 acc[2][2][4][2];
#pragma unroll
        for (int ai = 0; ai < 2; ++ai)
#pragma unroll
            for (int bj = 0; bj < 2; ++bj)
#pragma unroll
                for (int m = 0; m < 4; ++m) { acc[ai][bj][m][0] = (f32x4){0.f, 0.f, 0.f, 0.f}; acc[ai][bj][m][1] = (f32x4){0.f, 0.f, 0.f, 0.f}; }
        for (int n = 0; n < 4; ++n) {
            const bf16_t* Y = (const bf16_t*)(a->ws + (size_t)n * 2 * U); const bf16_t* W = (const bf16_t*)(a->ws + WS_WB) + (size_t)n * 1024 * 512;
            const bool ge = l == 0 && n == 0 && j < NGE;
            const bf16_t* GT = ge ? (const bf16_t*)(a->ws + WS_GE) : (const bf16_t*)(a->ws + WS_GATES + (size_t)n * 4 * U); const int gld = ge ? NGE * 256 : 1024;
            const bf16_t* GN = (const bf16_t*)(a->ws + WS_GATES + (size_t)(n < 3 ? n + 1 : 3) * 4 * U);
            AMapId am{(rb + R0) * 512 + C0, 512};
            gemm_tile<AMapId, false>(Y, W, 512, am, (j * 256 + bperm(R0)) * 512 + C0, acc, shm); EPI_LANES;
#pragma unroll
            for (int ai = 0; ai < 2; ++ai) {
                u32x4 gw[4][2], gn[4][2]; float rs[4];
#pragma unroll
                for (int m = 0; m < 4; ++m) { const int row = rb + ai * 128 + wr * 64 + m * 16 + fr;
                    rs[m] = 1.f; if (n == 0) { const float* sq = (const float*)(a->ws + WS_SSQ) + (size_t)row * 2; rs[m] = rsqrtf((sq[0] + sq[1]) * (1.f / 512.f) + EPS); }
#pragma unroll
                    for (int bj = 0; bj < 2; ++bj) { const int col = j * 256 + bj * 128 + wc * 32 + fq * 8;
                        gw[m][bj] = *(const u32x4*)(GT + (size_t)row * gld + col); gn[m][bj] = *(const u32x4*)(GN + (size_t)row * 1024 + col); } }
#pragma unroll
                for (int m = 0; m < 4; ++m) { const int row = rb + ai * 128 + wr * 64 + m * 16 + fr;
#pragma unroll
                    for (int bj = 0; bj < 2; ++bj) { const int col = j * 256 + bj * 128 + wc * 32 + fq * 8; const u32x4 g2 = gw[m][bj], g3 = gn[m][bj]; u32x4 w;
#pragma unroll
                        for (int nn = 0; nn < 2; ++nn) { f32x4 v = acc[ai][bj][m][nn] * rs[m];
                            float s0 = lo_bf(g2[2 * nn]), s1 = hi_bf(g2[2 * nn]), s2 = lo_bf(g2[2 * nn + 1]), s3 = hi_bf(g2[2 * nn + 1]);
                            if (n < 3) { s0 *= __builtin_amdgcn_rcpf(fmaxf(lo_bf(g3[2 * nn]), 1e-30f)); s1 *= __builtin_amdgcn_rcpf(fmaxf(hi_bf(g3[2 * nn]), 1e-30f));
                                         s2 *= __builtin_amdgcn_rcpf(fmaxf(lo_bf(g3[2 * nn + 1]), 1e-30f)); s3 *= __builtin_amdgcn_rcpf(fmaxf(hi_bf(g3[2 * nn + 1]), 1e-30f)); }
                            v[0] *= s0; v[1] *= s1; v[2] *= s2; v[3] *= s3; acc[ai][bj][m][nn] = v;
                            w[2 * nn] = cvtpk(v[0], v[1]); w[2 * nn + 1] = cvtpk(v[2], v[3]); }
                        if (n == 3) *(u32x4*)(ACC + (size_t)row * 1024 + col) = w; } }
            }
        }
    }
}
__device__ __forceinline__ void ph_wout(KArgs a, int l, char* shm) {
    int R0, C0; stage_coords(R0, C0);
    const int nrt = n_row_tiles(l);
    const bf16_t* ACC = (const bf16_t*)(a->ws + WS_H); const bf16_t* W = (const bf16_t*)(a->ws + WS_WO);
    for (int k = 0; ; ++k) { const int u = xcd_unit(k, nrt * 4); if (u >= nrt * 4) break;
        const int i = u >> 2, j = u & 3; const int rb = row_tile_base(l, i);
        f32x4 acc[2][2][4][2];
        AMapId am{(rb + R0) * 1024 + C0, 1024};
        gemm_tile(ACC, W, 1024, am, (j * 256 + bperm(R0)) * 1024 + C0, acc, shm); EPI_LANES;
#pragma unroll
        for (int ai = 0; ai < 2; ++ai)
#pragma unroll
            for (int m = 0; m < 4; ++m) { const int row = rb + ai * 128 + wr * 64 + m * 16 + fr;
                const float* xin = l == 0 ? xrow_in(a, row) : (const float*)xrow(a, row); float* xo = xrow(a, row); const float* g1 = modp(a, l, row, 2);
                f32x4 xi[2][2], gg[2][2];
#pragma unroll
                for (int bj = 0; bj < 2; ++bj)
#pragma unroll
                    for (int nn = 0; nn < 2; ++nn) { const int col = j * 256 + bj * 128 + wc * 32 + fq * 8 + nn * 4; xi[bj][nn] = *(const f32x4*)(xin + col); gg[bj][nn] = *(const f32x4*)(g1 + col); }
#pragma unroll
                for (int bj = 0; bj < 2; ++bj)
#pragma unroll
                    for (int nn = 0; nn < 2; ++nn) { const int col = j * 256 + bj * 128 + wc * 32 + fq * 8 + nn * 4; const f32x4 v = acc[ai][bj][m][nn];
                        *(f32x4*)(xo + col) = xi[bj][nn] + gg[bj][nn] * v; } }
    }
}

__device__ __forceinline__ void ph_norm2(KArgs a, int l, char* shm) {
    float* wrt = (float*)shm;
    const int tid = ltid(), lane = tid & 63, wv = tid >> 6;
    for (int i = tid; i < 4 * 1024; i += NTHREADS) { const int k = i >> 2, j = i & 3; wrt[j * 1024 + k] = a->in[29][(size_t)l * 4096 + i]; }
    for (int i = tid; i < 16 * 1024; i += NTHREADS) { const int k = i >> 4, j = i & 15; wrt[(4 + j) * 1024 + k] = a->in[31][(size_t)l * 16384 + i]; }
    __syncthreads();
    const float* g = a->in[7] + l * 1024; bf16_t* H = (bf16_t*)(a->ws + WS_H);
    int* cnt = (int*)(a->ws + WS_CNT) + l * 16; int* TE = (int*)(a->ws + WS_TOKE); int* TP = (int*)(a->ws + WS_TOKP); float* TW = (float*)(a->ws + WS_TOKW);
    int* lcnt = (int*)(shm + 20 * 1024 * 4); int* lbase = lcnt + 16; int* lrec = lbase + 16;
    float* rbias = (float*)(lrec + 72 * 4);
    if (tid < 16) lcnt[tid] = 0;
    if (tid < 4) rbias[tid] = a->in[30][l * 4 + tid]; else if (tid < 20) rbias[tid] = a->in[32][l * 16 + tid - 4];
    for (int i = tid; i < 72 * 4; i += NTHREADS) lrec[i] = -1;
    __syncthreads();
    auto next_it = [&](int it) { for (; it < 9; ++it) { const int row = blockIdx.x * 8 + wv + it * gridDim.x * 8; if (row >= T) return 9; const int pos = row % SEQ; if (!(l == 1 && pos < CTX)) return it; } return 9; };
    int it = next_it(0); f32x4 v[4];
    {   const float* x = xrow(a, it < 9 ? blockIdx.x * 8 + wv + it * gridDim.x * 8 : 0);
#pragma unroll
        for (int i = 0; i < 4; ++i) v[i] = *(const f32x4*)(x + i * 256 + lane * 4); }
    while (it < 9) { const int row = blockIdx.x * 8 + wv + it * gridDim.x * 8;
        const int nit = next_it(it + 1); f32x4 nv[4];
        const float* sh = modp(a, l, row, 3); const float* sc = modp(a, l, row, 4);
        float ss = 0.f;
#pragma unroll
        for (int i = 0; i < 4; ++i) ss += v[i][0] * v[i][0] + v[i][1] * v[i][1] + v[i][2] * v[i][2] + v[i][3] * v[i][3];
        ss = wave_sum(ss); const float inv = rsqrtf(ss * (1.f / 1024.f) + EPS);
        f32x4 gg[4], s1[4], s0[4];
#pragma unroll
        for (int i = 0; i < 4; ++i) { const int c = i * 256 + lane * 4; gg[i] = *(const f32x4*)(g + c); s1[i] = *(const f32x4*)(sc + c); s0[i] = *(const f32x4*)(sh + c); }
#pragma unroll
        for (int i = 0; i < 4; ++i) { const int c = i * 256 + lane * 4;
#pragma unroll
            for (int j = 0; j < 4; ++j) v[i][j] = v[i][j] * inv * gg[i][j] * (1.f + s1[i][j]) + s0[i][j];
            u32x2 w = {cvtpk(v[i][0], v[i][1]), cvtpk(v[i][2], v[i][3])}; *(u32x2*)(H + (size_t)row * 1024 + c) = w; }
        __builtin_amdgcn_sched_barrier(0);
        { const float* xn = xrow(a, nit < 9 ? blockIdx.x * 8 + wv + nit * gridDim.x * 8 : row);
#pragma unroll
          for (int i = 0; i < 4; ++i) nv[i] = *(const f32x4*)(xn + i * 256 + lane * 4); }
        __builtin_amdgcn_sched_barrier(0);
        float lg[4];
#pragma unroll
        for (int j = 0; j < 4; ++j) { float s = 0.f;
#pragma unroll
            for (int i = 0; i < 4; ++i) { const f32x4 w = *(const f32x4*)(wrt + j * 1024 + i * 256 + lane * 4); s += v[i][0] * w[0] + v[i][1] * w[1] + v[i][2] * w[2] + v[i][3] * w[3]; }
            lg[j] = wave_sum(s) + rbias[j]; }
        int gi = 0; float gm = lg[0];
#pragma unroll
        for (int j = 1; j < 4; ++j) if (lg[j] > gm) { gm = lg[j]; gi = j; }
        float den = 0.f;
#pragma unroll
        for (int j = 0; j < 4; ++j) den += __expf(lg[j] - gm);
        const float pg = 1.f / den;
        float le[4];
#pragma unroll
        for (int j = 0; j < 4; ++j) { float s = 0.f; const float* wp = wrt + (4 + gi * 4 + j) * 1024;
#pragma unroll
            for (int i = 0; i < 4; ++i) { const f32x4 w = *(const f32x4*)(wp + i * 256 + lane * 4); s += v[i][0] * w[0] + v[i][1] * w[1] + v[i][2] * w[2] + v[i][3] * w[3]; }
            le[j] = wave_sum(s) + rbias[4 + gi * 4 + j]; }
        int i1 = 0; float m1 = le[0];
#pragma unroll
        for (int j = 1; j < 4; ++j) if (le[j] > m1) { m1 = le[j]; i1 = j; }
        int i2 = -1; float m2 = -3.0e38f;
#pragma unroll
        for (int j = 0; j < 4; ++j) if (j != i1 && le[j] > m2) { m2 = le[j]; i2 = j; }
        if (i2 < 0) i2 = (i1 + 1) & 3;
        const float e2 = __expf(m2 - m1); const float w1 = 1.f / (1.f + e2), w2 = e2 / (1.f + e2);
        if (lane == 0) {
            const int ea = gi * 4 + i1, eb = gi * 4 + i2;
            const int pa = atomicAdd(&lcnt[ea], 1), pb = atomicAdd(&lcnt[eb], 1);
            TE[row * 2] = ea; TE[row * 2 + 1] = eb; TW[row * 2] = pg * w1; TW[row * 2 + 1] = pg * w2;
            const int sl = it * 8 + wv; lrec[sl * 4] = ea; lrec[sl * 4 + 1] = eb; lrec[sl * 4 + 2] = pa; lrec[sl * 4 + 3] = pb;
        }
#pragma unroll
        for (int i = 0; i < 4; ++i) v[i] = nv[i];
        it = nit;
    }
    __syncthreads();
    if (tid < 16) lbase[tid] = atomicAdd(&cnt[tid], lcnt[tid]);
    __syncthreads();
    if (tid < 72 * 2) { const int sl = tid >> 1, k = tid & 1; const int row = blockIdx.x * 8 + (sl & 7) + (sl >> 3) * gridDim.x * 8;
        if (row < T && lrec[sl * 4] >= 0) { const int e = lrec[sl * 4 + k]; const int p = lbase[e] + lrec[sl * 4 + 2 + k]; TP[row * 2 + k] = p; ((int*)(a->ws + WS_LIST))[e * T + p] = row; } }
}
__device__ __forceinline__ void moe_offsets(KArgs a, int l, int* off  ) {
    if (ltid() == 0) { const int* cnt = (const int*)(a->ws + WS_CNT) + l * 16; int o = 0;
        for (int e = 0; e < 16; ++e) { const int n = __hip_atomic_load(&cnt[e], __ATOMIC_RELAXED, __HIP_MEMORY_SCOPE_AGENT); off[e] = o; off[20 + e] = n; o += ((n + 255) >> 8) << 8; }
        off[16] = o; }
    __syncthreads();
}
__device__ __forceinline__ int moe_expert_of(const int* off, int s0) { int e = 0; for (int q = 1; q < 16; ++q) e = (s0 >= off[q]) ? q : e; return e; }
__device__ __forceinline__ void ph_moe1(KArgs a, int l, char* shm) {
    int* off = (int*)(shm + LDS_MAIN + 16); moe_offsets(a, l, off);
    int R0, C0; stage_coords(R0, C0);
    const bf16_t* H = (const bf16_t*)(a->ws + WS_H); const int* LIST = (const int*)(a->ws + WS_LIST); bf16_t* MA = (bf16_t*)(a->ws + WS_MOEA);
    const int nrt = off[16] >> 8;
    for (int k = 0; ; ++k) { const int u = xcd_unit(k, nrt * 4); if (u >= nrt * 4) break;
        const int i = u >> 2, j = u & 3; const int s0 = i * 256; const int e = moe_expert_of(off, s0);
        AMapG am;
#pragma unroll
        for (int q = 0; q < 4; ++q) { const int p = s0 - off[e] + R0 + 64 * q; const int tk = p < off[20 + e] ? LIST[e * T + p] : 0; am.o[q] = tk * 1024 + C0; }
        f32x4 acc[2][2][4][2];
        gemm_tile(H, (const bf16_t*)(a->ws + WS_E13) + (size_t)e * 1024 * 1024, 1024, am, (j * 256 + R0) * 1024 + C0, acc, shm); EPI_LANES;
#pragma unroll
        for (int ai = 0; ai < 2; ++ai)
#pragma unroll
            for (int m = 0; m < 4; ++m) { const int slot = s0 + ai * 128 + wr * 64 + m * 16 + fr; const int col = j * 128 + wc * 32 + fq * 8;
                const f32x4 p0 = acc[ai][0][m][0], q0 = acc[ai][0][m][1], p1 = acc[ai][1][m][0], q1 = acc[ai][1][m][1];
                u32x4 w = {cvtpk(siluf_(p0[0]) * q0[0], siluf_(p0[1]) * q0[1]), cvtpk(siluf_(p0[2]) * q0[2], siluf_(p0[3]) * q0[3]),
                           cvtpk(siluf_(p1[0]) * q1[0], siluf_(p1[1]) * q1[1]), cvtpk(siluf_(p1[2]) * q1[2], siluf_(p1[3]) * q1[3])};
                *(u32x4*)(MA + (size_t)slot * 512 + col) = w; }
    }
    if (l == 1) ph_cvt(a, 1, shm, 5, (nrt * 4) % (int)gridDim.x);
}
__device__ __forceinline__ void ph_moe2(KArgs a, int l, char* shm) {
    int* off = (int*)(shm + LDS_MAIN + 16); moe_offsets(a, l, off);
    int R0, C0; stage_coords(R0, C0);
    const bf16_t* MA = (const bf16_t*)(a->ws + WS_MOEA); bf16_t* MO = (bf16_t*)(a->ws + WS_MOEO);
    const int nrt = off[16] >> 8;
    for (int k = 0; ; ++k) { const int u = xcd_unit(k, nrt * 4); if (u >= nrt * 4) break;
        const int i = u >> 2, j = u & 3; const int s0 = i * 256; const int e = moe_expert_of(off, s0);
        AMapId am{(s0 + R0) * 512 + C0, 512};
        f32x4 acc[2][2][4][2];
        gemm_tile(MA, (const bf16_t*)(a->ws + WS_E2) + (size_t)e * 1024 * 512, 512, am, (j * 256 + bperm(R0)) * 512 + C0, acc, shm); EPI_LANES;
#pragma unroll
        for (int ai = 0; ai < 2; ++ai)
#pragma unroll
            for (int m = 0; m < 4; ++m) { const int slot = s0 + ai * 128 + wr * 64 + m * 16 + fr;
#pragma unroll
                for (int bj = 0; bj < 2; ++bj) { const int col = j * 256 + bj * 128 + wc * 32 + fq * 8; const f32x4 v = acc[ai][bj][m][0], v2 = acc[ai][bj][m][1];
                        u32x4 w = {cvtpk(v[0], v[1]), cvtpk(v[2], v[3]), cvtpk(v2[0], v2[1]), cvtpk(v2[2], v2[3])}; *(u32x4*)(MO + (size_t)slot * 1024 + col) = w; } }
    }
}
__device__ __forceinline__ void moe_row(KArgs a, int l, int row, int lane, const int* off, f32x4 (&o)[4]) {
    const int* TE = (const int*)(a->ws + WS_TOKE); const int* TP = (const int*)(a->ws + WS_TOKP); const float* TW = (const float*)(a->ws + WS_TOKW);
    const bf16_t* MO = (const bf16_t*)(a->ws + WS_MOEO); const float* g2 = modp(a, l, row, 5);
    const int s1 = off[TE[row * 2]] + TP[row * 2], s2 = off[TE[row * 2 + 1]] + TP[row * 2 + 1]; const float w1 = TW[row * 2], w2 = TW[row * 2 + 1];
#pragma unroll
    for (int i = 0; i < 4; ++i) { const int c = i * 256 + lane * 4; const u32x2 p = *(const u32x2*)(MO + (size_t)s1 * 1024 + c), q = *(const u32x2*)(MO + (size_t)s2 * 1024 + c); const f32x4 gg = *(const f32x4*)(g2 + c);
        o[i] = (f32x4){gg[0] * (w1 * lo_bf(p[0]) + w2 * lo_bf(q[0])), gg[1] * (w1 * hi_bf(p[0]) + w2 * hi_bf(q[0])), gg[2] * (w1 * lo_bf(p[1]) + w2 * lo_bf(q[1])), gg[3] * (w1 * hi_bf(p[1]) + w2 * hi_bf(q[1]))}; }
}
__device__ __forceinline__ void ph_final(KArgs a, char* shm) {
    int* off = (int*)(shm + LDS_MAIN + 16); moe_offsets(a, 1, off);
    const int tid = ltid(); const int lane = tid & 63, wv = tid >> 6;
    for (int r = blockIdx.x * 8 + wv; r < NB * LAT; r += gridDim.x * 8) { const int b = r / LAT, t = r - b * LAT; const int row = b * SEQ + CTX + t;
        f32x4 mo[4], xv[4]; moe_row(a, 1, row, lane, off, mo); float* x = a->out + (size_t)r * D;
#pragma unroll
        for (int i = 0; i < 4; ++i) xv[i] = *(const f32x4*)(x + i * 256 + lane * 4);
#pragma unroll
        for (int i = 0; i < 4; ++i) *(f32x4*)(x + i * 256 + lane * 4) = xv[i] + mo[i]; }
}

constexpr int LDS_BYTES = LDS_MAIN + 12288;
constexpr int NPL = 13, NPH = 2 + 2 * NPL;

__global__ void __launch_bounds__(NTHREADS, 2) mk_fwd(Args a_) {
    extern __shared__ __attribute__((aligned(16))) char shm[];
    asm volatile("s_nop 0\n\ts_nop 0\n\t");
    if (threadIdx.x < 4) ((volatile LAS unsigned*)(shm + LDS_MAIN))[threadIdx.x] = 0u;
    if ((threadIdx.x & 63) == 0) *(volatile int*)(shm + LDS_WTAB + 4 * hw_slot()) = (int)(threadIdx.x >> 6);
    __syncthreads();
    const int lo = kargs()->ph_lo, hi = kargs()->ph_hi;
    XcdBarrier bar; bar.bar = (unsigned*)(kargs()->ws + WS_CTL); bar.x = 0; bar.st = (volatile LAS unsigned*)(shm + LDS_MAIN);
    if (hi - lo > 1) bar = xcd_barrier_post((unsigned*)(kargs()->ws + WS_CTL), (volatile LAS unsigned*)(shm + LDS_MAIN));
#define IN(k) (lo <= (k) && (k) < hi)
#define SEAM(k) do { if (IN(k) && IN((k) + 1)) xcd_barrier(bar); } while (0)
    if (IN(0)) { ph_mod(kargs(), shm); ph_cvt(kargs(), 0, shm, 0); } SEAM(0);
    for (int l = 0; l < 2; ++l) {
        const int p0 = 1 + l * NPL;
        if (IN(p0 + 0)) { ph_norm1(kargs(), l, shm, l > 0); } SEAM(p0 + 0);
        if (IN(p0 + 1)) { ph_gemm_in(kargs(), l, shm); } SEAM(p0 + 1);
        if (IN(p0 + 2)) { lru::pass_a(kargs(), l, shm); } SEAM(p0 + 2);
        if (IN(p0 + 3)) { lru::pass_b(kargs(), l, shm); ph_prep(kargs(), l, shm); } SEAM(p0 + 3);
        if (IN(p0 + 4)) { ph_mix(kargs(), l, shm); } SEAM(p0 + 4);
        if (IN(p0 + 5)) { ssd::s2_scan(kargs()); gla::g2_scan(kargs()); } SEAM(p0 + 5);
        if (IN(p0 + 6)) { ph_ssd3(kargs(), l, shm); ph_gla3(kargs(), l, shm); } SEAM(p0 + 6);
        if (IN(p0 + 7)) { ph_gemm_gates(kargs(), l, shm); } SEAM(p0 + 7);
        if (IN(p0 + 8)) { ph_merge(kargs(), l, shm); if (l == 0) ph_cvt(kargs(), 0, shm, 1, 16); } SEAM(p0 + 8);
        if (IN(p0 + 9)) { ph_wout(kargs(), l, shm); if (l == 0) ph_cvt(kargs(), 1, shm, 2, 16); } SEAM(p0 + 9);
        if (IN(p0 + 10)) { ph_norm2(kargs(), l, shm); ph_cvt(kargs(), 1, shm, l == 0 ? 3 : 4); } SEAM(p0 + 10);
        if (IN(p0 + 11)) { ph_moe1(kargs(), l, shm); } SEAM(p0 + 11);
        if (IN(p0 + 12)) { ph_moe2(kargs(), l, shm); } SEAM(p0 + 12);
    }
    if (IN(1 + 2 * NPL)) { ph_final(kargs(), shm); }
#undef IN
#undef SEAM
}

extern "C" void kernel_launch(void* const* d_in, const int* in_sizes, int n_in, void* d_out, int out_size, void* d_ws, size_t ws_size, hipStream_t stream) {
    static int grid = 0;
    if (grid == 0) {
        if (n_in != 36 || out_size != NB * LAT * D || ws_size < WS_END) { fprintf(stderr, "kernel_launch: unexpected shapes (n_in %d out %d ws %zu need %zu)\n", n_in, out_size, ws_size, (size_t)WS_END); grid = -1; return; }
        int dev = 0, cus = 0;
        if (hipGetDevice(&dev) != hipSuccess || hipDeviceGetAttribute(&cus, hipDeviceAttributeMultiprocessorCount, dev) != hipSuccess) { grid = -1; return; }
        if (hipFuncSetAttribute((const void*)mk_fwd, hipFuncAttributeMaxDynamicSharedMemorySize, LDS_BYTES) != hipSuccess) { fprintf(stderr, "kernel_launch: hipFuncSetAttribute failed\n"); grid = -1; return; }
        int per_cu = 0;
        if (hipOccupancyMaxActiveBlocksPerMultiprocessor(&per_cu, (const void*)mk_fwd, NTHREADS, LDS_BYTES) != hipSuccess || per_cu < 1) { fprintf(stderr, "kernel_launch: occupancy query says %d\n", per_cu); }
        (void)hipGetLastError();
        grid = cus;
    }
    if (grid < 0) return;
    hipMemsetAsync((char*)d_ws + WS_CTL, 0, 16384, stream);
    Args a{};
    for (int i = 0; i < 36; ++i) a.in[i] = (const float*)d_in[i];
    a.out = (float*)d_out; a.ws = (unsigned char*)d_ws;
#if MK_ONE_LAUNCH
    a.ph_lo = 0; a.ph_hi = NPH;
    hipLaunchKernelGGL(mk_fwd, dim3(grid), dim3(NTHREADS), LDS_BYTES, stream, a);
#else
    for (int p = 0; p < NPH; ++p) { a.ph_lo = p; a.ph_hi = p + 1; hipLaunchKernelGGL(mk_fwd, dim3(grid), dim3(NTHREADS), LDS_BYTES, stream, a); }
#endif
}
```
